# Optimizing an MI355X kernel written in HIP

```python
import math
import jax
import jax.numpy as jnp
from jax import lax
import numpy as np

D_MODEL = 1024
BATCH = 8
SEQ = 2048
DEPTH = 1
DEC_BATCH = 128
DEC_SEQ = 4
PAST_LEN = 16384
PAGE_SIZE = 128

GLA_HEADS = 4
GLA_DK = D_MODEL // 8
GLA_DV = D_MODEL // 4
GLA_LOWRANK = 16
GLA_TAU = 16.0
GLA_CHUNK = 16
RET_HEADS = 4
RET_DK = D_MODEL // 4
RET_DV = D_MODEL // 2
RET_CHUNK = 128
ROPE_BASE = 10000.0

GK = GLA_HEADS * GLA_DK
GV = GLA_HEADS * GLA_DV
RK = RET_HEADS * RET_DK
RV = RET_HEADS * RET_DV
IN_SIZES = (GK, GK, GV, GV, GLA_LOWRANK, RK, RK, RV, RV, D_MODEL, D_MODEL)
D_IN = 2 * GK + 2 * GV + GLA_LOWRANK + 2 * RK + 2 * RV + 2 * D_MODEL

DEEPNORM_ALPHA = (2.0 * DEPTH) ** 0.25
DEEPNORM_BETA = (8.0 * DEPTH) ** -0.25
LN_EPS = 1e-5
HEAD_NORM_EPS = 1e-5

kernel_name = 'gla_retnet_gated_hybrid_step'

F32 = jnp.float32


def _split_in(p):
    cuts = [int(c) for c in np.cumsum(IN_SIZES)[:-1]]
    return jnp.split(p, cuts, axis=-1)


def _layernorm(x, g, b):
    x32 = x.astype(F32)
    mu = jnp.mean(x32, -1, keepdims=True)
    var = jnp.mean(jnp.square(x32 - mu), -1, keepdims=True)
    return ((x32 - mu) * lax.rsqrt(var + LN_EPS)).astype(x.dtype) * g + b


def _head_rmsnorm(o):
    B, T, H, DV = o.shape
    o = o * lax.rsqrt(jnp.mean(jnp.square(o), -1, keepdims=True) + HEAD_NORM_EPS)
    return o.reshape(B, T, H * DV)


def _head_groupnorm(o):
    B, T, H, DV = o.shape
    mu = jnp.mean(o, -1, keepdims=True)
    var = jnp.mean(jnp.square(o - mu), -1, keepdims=True)
    return ((o - mu) * lax.rsqrt(var + HEAD_NORM_EPS)).reshape(B, T, H * DV)


def _rotary(x, pos):
    half = x.shape[-1] // 2
    inv_freq = ROPE_BASE ** (-jnp.arange(half, dtype=F32) / half)
    ang = pos.astype(F32)[:, None] * inv_freq[None, :]
    cos = jnp.cos(ang)[None, :, None, :]
    sin = jnp.sin(ang)[None, :, None, :]
    x32 = x.astype(F32)
    x1, x2 = x32[..., :half], x32[..., half:]
    return jnp.concatenate([x1 * cos - x2 * sin, x1 * sin + x2 * cos], axis=-1)


def _to_chunks(a, L):
    B, T, H, d = a.shape
    return a.astype(F32).reshape(B, T // L, L, H, d).transpose(1, 0, 3, 2, 4)


def _from_chunks(o):
    N, B, H, L, d = o.shape
    return o.transpose(1, 0, 3, 2, 4).reshape(B, N * L, H, d)


def _gla(q, k, v, log_alpha, s0):
    T = q.shape[1]
    L = math.gcd(T, GLA_CHUNK)
    causal = jnp.tril(jnp.ones((L, L), dtype=bool))

    def step(S, inp):
        qc, kc, vc, gc = inp
        b = jnp.cumsum(gc, axis=2)
        q_dec = qc * jnp.exp(b)
        k_dec = kc * jnp.exp(-b)
        A = jnp.where(causal, jnp.einsum('bhtd,bhsd->bhts', q_dec, k_dec), 0.0)
        o = jnp.einsum('bhtd,bhdv->bhtv', q_dec, S) + jnp.einsum('bhts,bhsv->bhtv', A, vc)
        b_last = b[:, :, -1:, :]
        S_new = jnp.exp(b_last[:, :, 0, :])[..., None] * S + jnp.einsum(
            'bhsd,bhsv->bhdv', kc * jnp.exp(b_last - b), vc)
        return S_new, o

    S, o = lax.scan(step, s0.astype(F32),
                    (_to_chunks(q, L), _to_chunks(k, L), _to_chunks(v, L), _to_chunks(log_alpha, L)))
    return _from_chunks(o), S


def _retention(q, k, v, s0):
    T, H = q.shape[1], q.shape[2]
    L = math.gcd(T, RET_CHUNK)
    log_gamma = jnp.log1p(-jnp.exp2(-5.0 - jnp.arange(H, dtype=F32)))
    idx = jnp.arange(L, dtype=F32)
    diff = idx[:, None] - idx[None, :]
    decay_intra = jnp.where(diff[None] >= 0, jnp.exp(jnp.maximum(diff, 0.0)[None] * log_gamma[:, None, None]), 0.0)
    decay_read = jnp.exp((idx + 1.0)[None, :] * log_gamma[:, None])
    decay_write = jnp.exp((L - 1.0 - idx)[None, :] * log_gamma[:, None])
    decay_chunk = jnp.exp(L * log_gamma)

    def step(S, inp):
        qc, kc, vc = inp
        A = jnp.einsum('bhtd,bhsd->bhts', qc, kc) * decay_intra
        o = jnp.einsum('bhts,bhsv->bhtv', A, vc) + jnp.einsum(
            'bhtd,bhdv->bhtv', qc, S) * decay_read[None, :, :, None]
        S_new = decay_chunk[None, :, None, None] * S + jnp.einsum(
            'bhsd,bhsv->bhdv', kc * decay_write[None, :, :, None], vc)
        return S_new, o

    S, o = lax.scan(step, s0.astype(F32), (_to_chunks(q, L), _to_chunks(k, L), _to_chunks(v, L)))
    return _from_chunks(o), S


def _layer(x, c, s_gla, s_ret, pos, w_ada, b_ada, w_in, w_lr2, b_lr2, gla_norm_g, ret_norm_g,
           w_branch_gla, w_branch_ret, w_out, ln_g, ln_b):
    B, T, _ = x.shape
    shift, scale, gate = jnp.split(c @ w_ada + b_ada, 3, axis=-1)
    h = x * (1.0 + scale[:, None, :]) + shift[:, None, :]
    qg, kg, vg, zg, lr, qr, kr, vr, zr, mg, mr = _split_in(h @ w_in)

    log_alpha = jax.nn.log_sigmoid((lr @ w_lr2 + b_lr2).astype(F32)) / GLA_TAU
    o_g, s_gla_new = _gla(qg.reshape(B, T, GLA_HEADS, GLA_DK) * (GLA_DK ** -0.5),
                          kg.reshape(B, T, GLA_HEADS, GLA_DK),
                          vg.reshape(B, T, GLA_HEADS, GLA_DV),
                          log_alpha.reshape(B, T, GLA_HEADS, GLA_DK), s_gla)
    o_g = _head_rmsnorm(o_g).astype(x.dtype) * gla_norm_g * jax.nn.silu(zg)

    o_r, s_ret_new = _retention(_rotary(qr.reshape(B, T, RET_HEADS, RET_DK), pos),
                                _rotary(kr.reshape(B, T, RET_HEADS, RET_DK), pos) * (RET_DK ** -0.5),
                                vr.reshape(B, T, RET_HEADS, RET_DV), s_ret)
    o_r = _head_groupnorm(o_r).astype(x.dtype) * ret_norm_g * jax.nn.silu(zr)

    merged = jax.nn.sigmoid(mg) * (o_g @ w_branch_gla) + jax.nn.sigmoid(mr) * (o_r @ w_branch_ret)
    y = _layernorm(DEEPNORM_ALPHA * x + gate[:, None, :] * (merged @ w_out), ln_g, ln_b)
    return y, s_gla_new.astype(s_gla.dtype), s_ret_new.astype(s_ret.dtype)


def setup_inputs(seed: int = 0) -> dict:
    key = jax.random.key(seed)
    ks = jax.random.split(key, 20)
    nrm = jax.random.normal
    col_scale = jnp.concatenate([
        jnp.full((s,), sc, dtype=F32) for s, sc in zip(
            IN_SIZES, (1.0, 1.0, DEEPNORM_BETA, 1.0, 1.0, 1.0, 1.0, DEEPNORM_BETA, 1.0, 1.0, 1.0))])
    return {
        'x_prompt': nrm(ks[0], (BATCH, SEQ, D_MODEL), F32),
        'x_sample': nrm(ks[1], (DEC_BATCH, DEC_SEQ, D_MODEL), F32),
        'state_gla': 0.1 * nrm(ks[2], (DEPTH, DEC_BATCH, GLA_HEADS, GLA_DK, GLA_DV), F32),
        'state_ret': 0.1 * nrm(ks[3], (DEPTH, DEC_BATCH, RET_HEADS, RET_DK, RET_DV), F32),
        'c_prompt': nrm(ks[4], (BATCH, D_MODEL), F32),
        'c_sample': nrm(ks[5], (DEC_BATCH, D_MODEL), F32),
        'w_ada': 0.5 * D_MODEL ** -0.5 * nrm(ks[6], (DEPTH, D_MODEL, 3 * D_MODEL), F32),
        'b_ada': 0.02 * nrm(ks[7], (DEPTH, 3 * D_MODEL), F32),
        'w_in': D_MODEL ** -0.5 * nrm(ks[8], (DEPTH, D_MODEL, D_IN), F32) * col_scale,
        'w_lr2': GLA_LOWRANK ** -0.5 * nrm(ks[9], (DEPTH, GLA_LOWRANK, GK), F32),
        'b_lr2': 0.1 * nrm(ks[10], (DEPTH, GK), F32),
        'gla_norm_g': 1.0 + 0.02 * nrm(ks[11], (DEPTH, GV), F32),
        'ret_norm_g': 1.0 + 0.02 * nrm(ks[12], (DEPTH, RV), F32),
        'w_branch_gla': DEEPNORM_BETA * GV ** -0.5 * nrm(ks[13], (DEPTH, GV, D_MODEL), F32),
        'w_branch_ret': DEEPNORM_BETA * RV ** -0.5 * nrm(ks[14], (DEPTH, RV, D_MODEL), F32),
        'w_out': DEEPNORM_BETA * D_MODEL ** -0.5 * nrm(ks[15], (DEPTH, D_MODEL, D_MODEL), F32),
        'ln_g': 1.0 + 0.02 * nrm(ks[16], (DEPTH, D_MODEL), F32),
        'ln_b': 0.02 * nrm(ks[17], (DEPTH, D_MODEL), F32),
    }


def reference(x_prompt, x_sample, state_gla, state_ret, c_prompt, c_sample, w_ada, b_ada, w_in,
              w_lr2, b_lr2, gla_norm_g, ret_norm_g, w_branch_gla, w_branch_ret, w_out, ln_g, ln_b):
    n_prompt, t_prompt = x_prompt.shape[0], x_prompt.shape[1]
    pos_prompt = jnp.arange(t_prompt, dtype=jnp.int32)
    pos_sample = PAST_LEN + jnp.arange(x_sample.shape[1], dtype=jnp.int32)
    y_p, y_s = x_prompt, x_sample
    gla_p, ret_p, gla_s, ret_s = [], [], [], []
    for l in range(DEPTH):
        weights = (w_ada[l], b_ada[l], w_in[l], w_lr2[l], b_lr2[l], gla_norm_g[l], ret_norm_g[l],
                   w_branch_gla[l], w_branch_ret[l], w_out[l], ln_g[l], ln_b[l])
        zero_gla = jnp.zeros((n_prompt, GLA_HEADS, GLA_DK, GLA_DV), x_prompt.dtype)
        zero_ret = jnp.zeros((n_prompt, RET_HEADS, RET_DK, RET_DV), x_prompt.dtype)
        y_p, sg_p, sr_p = _layer(y_p, c_prompt, zero_gla, zero_ret, pos_prompt, *weights)
        y_s, sg_s, sr_s = _layer(y_s, c_sample, state_gla[l], state_ret[l], pos_sample, *weights)
        gla_p.append(sg_p)
        ret_p.append(sr_p)
        gla_s.append(sg_s)
        ret_s.append(sr_s)
    return (y_p, y_s, jnp.stack(gla_p), jnp.stack(ret_p), jnp.stack(gla_s), jnp.stack(ret_s))
```

```cpp
#include <hip/hip_runtime.h>
#include <cstdio>
#include <cstdint>
#include <cstring>

#define LAS __attribute__((address_space(3)))
#define DI __device__ __forceinline__
typedef unsigned short bf16_t;
typedef short bf16x8 __attribute__((ext_vector_type(8)));
typedef float f32x4 __attribute__((ext_vector_type(4)));
typedef unsigned u32x4 __attribute__((ext_vector_type(4)));
typedef unsigned u32x2 __attribute__((ext_vector_type(2)));

constexpr int DM = 1024;
constexpr int NTP = 16384, NTS = 512, NTOK = NTP + NTS, TP = 2048;
constexpr int NB_P = 8, NB_S = 128;
constexpr int PW = 11264;
constexpr int NIN = 11520;
constexpr int C_QG = 0, C_KG = 512, C_VG = 1024, C_ZG = 2048, C_QR = 3072, C_KR = 4096, C_VR = 5120, C_ZR = 7168, C_MG = 9216, C_MR = 10240;
constexpr int UW = 3072;
constexpr int CH = 64;
constexpr int NCHP = NTP / CH;
constexpr float LN_EPS = 1e-5f, HN_EPS = 1e-5f;
constexpr float DN_ALPHA = 1.189207115002721f;

constexpr size_t OUT_Y = 0, OUT_SGP = 17301504, OUT_SRP = 18350080, OUT_SGS = 22544384, OUT_SRS = 39321600;

constexpr size_t MiB = 1024 * 1024;
constexpr size_t WS_CTL = 0;
constexpr size_t WS_ADA = 1 * MiB;
constexpr size_t WS_COS = 3 * MiB;
constexpr size_t WS_SIN = 5 * MiB;
constexpr size_t WS_LR = 7 * MiB;
constexpr size_t WS_LAM = 9 * MiB;
constexpr size_t WS_YST = 10 * MiB;
constexpr size_t WS_STAT = 13 * MiB;
constexpr size_t WS_WIN = 30 * MiB;
constexpr size_t WS_WBR = 54 * MiB;
constexpr size_t WS_WO = 61 * MiB;
constexpr size_t WS_H = 64 * MiB;
constexpr size_t WS_MRG = 98 * MiB;
constexpr size_t WS_O = 132 * MiB;
constexpr size_t WS_U = 232 * MiB;
constexpr size_t WS_P = 332 * MiB;
constexpr size_t WS_END = 700 * MiB;
constexpr int CW_BAR = 4096;

constexpr int LDS_MISC = 147456;
constexpr int LDS_BYTES = 147456 + 1024;

struct Params {
    const float* in[18];
    float* out;
    unsigned char* ws;
    int ph_lo, ph_hi;
};

DI unsigned f2bf(float f) { unsigned u = __builtin_bit_cast(unsigned, f); return (u + 0x7fffu + ((u >> 16) & 1u)) >> 16; }
DI unsigned pk2(float lo, float hi) { return f2bf(lo) | (f2bf(hi) << 16); }
DI float bflo(unsigned w) { return __builtin_bit_cast(float, w << 16); }
DI float bfhi(unsigned w) { return __builtin_bit_cast(float, w & 0xffff0000u); }
DI float bf1(bf16_t b) { return __builtin_bit_cast(float, ((unsigned)b) << 16); }
DI float wave_sum(float v) {
#pragma unroll
    for (int o = 1; o < 64; o <<= 1) v += __shfl_xor(v, o);
    return v;
}
DI float sigmoidf_(float x) { return 1.0f / (1.0f + __expf(-x)); }
DI float siluf_(float x) { return x / (1.0f + __expf(-x)); }
#define LDS_WAIT() asm volatile("s_waitcnt lgkmcnt(0)" ::: "memory")

namespace pg8 {
constexpr int BM = 256, BK = 64, HALF = 128, HTB = HALF * BK * 2, STAGE_BYTES = 8 * HTB, NXCD = 8, WGM = 8;
DI int lds_byte(int r, int c) { const int st = (r >> 4) * 2 + (c >> 5), rr = r & 15, cc = c & 31, ob = rr * 64 + cc * 2; return st * 1024 + (ob ^ (((ob >> 9) & 1) << 5)); }
DI void stage_rc(int b, int& R, int& C) { const int st = b / 1024, sb = b % 1024, swz = sb ^ (((sb >> 9) & 1) << 5); R = (st >> 1) * 16 + swz / 64; C = (st & 1) * 32 + (swz % 64) / 2; }
DI int perm32(int rho) { const int n = rho >> 4, i = rho & 15; return 8 * (i >> 2) + 4 * n + (i & 3); }
struct Unit { int pm, pn; };
struct Gemm { const bf16_t* A; const bf16_t* Bt; int M, N, K; };
struct StaticOrder {
    int nM, nN, nwg, G, c;
    DI void init(int M, int N, int G_, int c_) { nM = M / BM; nN = N / BM; nwg = nM * nN; G = G_; c = c_; }
    DI bool next(int i, Unit& u) const {
        const long L = (long)i * G + c; if (L >= nwg) return false;
        int wgid = (int)L; { const int q = nwg / NXCD, r = nwg % NXCD, xcd = wgid % NXCD, off = wgid / NXCD; wgid = (xcd < r ? xcd * (q + 1) : r * (q + 1) + (xcd - r) * q) + off; }
        const int nig = WGM * nN, gid = wgid / nig, fm = gid * WGM, gsz = (nM - fm) < WGM ? (nM - fm) : WGM;
        u.pm = fm + ((wgid % nig) % gsz); u.pn = (wgid % nig) / gsz; return true;
    }
    DI void a_ready(const Unit&) const {}
    DI void done(const Unit&) const {}
};

template <class Epi, class Sched>
DI void gemm_phase(LAS unsigned char* lds, const Gemm g, const Sched& S, const Epi& E) {
    const int tid = threadIdx.x, wid = __builtin_amdgcn_readfirstlane(tid >> 6), lane = tid & 63, wr = wid >> 2, wc = wid & 3, fr = lane & 15, fq = lane >> 4;
    const int K = g.K, nt = K / BK;
    unsigned voffA[2], voffB[2];
#pragma unroll
    for (int i = 0; i < 2; ++i) { int R, C; stage_rc(tid * 16 + i * 8192, R, C); const int Rb = Epi::PERM ? ((R & ~31) + perm32(R & 31)) : R;
        voffA[i] = (unsigned)(R * K + C) * 2u; voffB[i] = (unsigned)(Rb * K + C) * 2u; }
    const size_t kstep = (size_t)(BK * 2);
    const size_t hstep = (size_t)HALF * K * 2;
    const size_t tstep = 2 * hstep;
    const unsigned ldsw = (unsigned)wid * 1024u;
    const int aoff = lds_byte(wr * 64 + fr, fq * 8), boff = lds_byte(wc * 32 + fr, fq * 8);
#define PG8_SA(b, h) (((b) * 2 + (h)) * HTB)
#define PG8_SB(b, h) ((4 + (b) * 2 + (h)) * HTB)
#define PG8_STAGE(bufoff, gbase, voff) do { _Pragma("unroll") for (int _i = 0; _i < 2; ++_i) \
        __builtin_amdgcn_global_load_lds((const unsigned*)((const char*)(gbase) + (voff)[_i]), (LAS unsigned*)(lds + (bufoff) + ldsw + _i * 8192), 16, 0, 0); } while (0)
#define PG8_LDA(dst, b, h) do { _Pragma("unroll") for (int m = 0; m < 4; ++m) _Pragma("unroll") for (int k = 0; k < 2; ++k) dst[m][k] = *(const LAS bf16x8*)(lds + PG8_SA(b, h) + aoff + m * 2048 + k * 1024); } while (0)
#define PG8_LDB(dst, b, h) do { _Pragma("unroll") for (int n = 0; n < 2; ++n) _Pragma("unroll") for (int k = 0; k < 2; ++k) dst[n][k] = *(const LAS bf16x8*)(lds + PG8_SB(b, h) + boff + n * 2048 + k * 1024); } while (0)
#define PG8_MMA(ai, bj, At, Bt) do { __builtin_amdgcn_s_setprio(1); _Pragma("unroll") for (int m = 0; m < 4; ++m) _Pragma("unroll") for (int n = 0; n < 2; ++n) _Pragma("unroll") for (int k = 0; k < 2; ++k) \
        acc[ai][bj][m][n] = __builtin_amdgcn_mfma_f32_16x16x32_bf16(Bt[n][k], At[m][k], acc[ai][bj][m][n], 0, 0, 0); __builtin_amdgcn_s_setprio(0); } while (0)
#define PG8_WAIT_V(n) asm volatile("s_waitcnt vmcnt(" #n ")" ::: "memory")
#define PG8_WAIT_L(n) asm volatile("s_waitcnt lgkmcnt(" #n ")" ::: "memory")
#define PG8_BAR __builtin_amdgcn_s_barrier()
#define PG8_SCHED __builtin_amdgcn_sched_barrier(0)
    Unit cur, nxt; int ui = 0;
    if (!S.next(0, cur)) return;
    f32x4 acc[2][2][4][2];
#pragma unroll
    for (int a = 0; a < 2; ++a)
#pragma unroll
        for (int b = 0; b < 2; ++b)
#pragma unroll
            for (int m = 0; m < 4; ++m)
#pragma unroll
                for (int n = 0; n < 2; ++n) acc[a][b][m][n] = (f32x4){0.f, 0.f, 0.f, 0.f};
    bf16x8 At[4][2], B0[2][2], B1[2][2];
    const char* cA = (const char*)g.A + (size_t)cur.pm * tstep; const char* cB = (const char*)g.Bt + (size_t)cur.pn * tstep;
    S.a_ready(cur);
    PG8_STAGE(PG8_SB(0, 0), cB, voffB); PG8_STAGE(PG8_SA(0, 0), cA, voffA); PG8_STAGE(PG8_SB(0, 1), cB + hstep, voffB); PG8_STAGE(PG8_SA(0, 1), cA + hstep, voffA);
    if (wr == 1) PG8_BAR;
    PG8_WAIT_V(4); PG8_BAR;
    PG8_STAGE(PG8_SB(1, 0), cB + kstep, voffB); PG8_STAGE(PG8_SA(1, 0), cA + kstep, voffA); PG8_STAGE(PG8_SB(1, 1), cB + hstep + kstep, voffB);
    PG8_WAIT_V(6); PG8_BAR;
    for (;;) {
        const bool has_next = S.next(ui + 1, nxt);
        const char* nA = has_next ? (const char*)g.A + (size_t)nxt.pm * tstep : cA; const char* nB = has_next ? (const char*)g.Bt + (size_t)nxt.pn * tstep : cB;
        for (int t = 0; t < nt; t += 2) {
            const bool last = (t == nt - 2);
            const char* a1 = cA + (size_t)(t + 1) * kstep;
            const char* a2 = last ? nA : cA + (size_t)(t + 2) * kstep; const char* b2 = last ? nB : cB + (size_t)(t + 2) * kstep;
            const char* a3 = a2 + kstep; const char* b3 = b2 + kstep;
            if (last && has_next) S.a_ready(nxt);
            if constexpr (Epi::MID_T > 0) { if (t == Epi::MID_T) E.mid(acc, cur, wr, wc, fr, fq); }
            PG8_LDB(B0, 0, 0); PG8_SCHED; PG8_LDA(At, 0, 0); PG8_STAGE(PG8_SA(1, 1), a1 + hstep, voffA);
            PG8_WAIT_L(8); PG8_BAR; PG8_WAIT_L(0); PG8_MMA(0, 0, At, B0); PG8_BAR; PG8_SCHED;
            PG8_LDB(B1, 0, 1); PG8_STAGE(PG8_SB(0, 0), b2, voffB);
            PG8_BAR; PG8_WAIT_L(0); PG8_MMA(0, 1, At, B1); PG8_BAR;
            PG8_LDA(At, 0, 1); PG8_STAGE(PG8_SA(0, 0), a2, voffA);
            PG8_BAR; PG8_WAIT_L(0); PG8_MMA(1, 0, At, B0); PG8_BAR; PG8_SCHED;
            PG8_STAGE(PG8_SB(0, 1), b2 + hstep, voffB);
            PG8_WAIT_V(6); PG8_BAR; PG8_MMA(1, 1, At, B1); PG8_BAR;
            PG8_LDB(B0, 1, 0); PG8_SCHED; PG8_LDA(At, 1, 0); PG8_STAGE(PG8_SA(0, 1), a2 + hstep, voffA);
            PG8_WAIT_L(8); PG8_BAR; PG8_WAIT_L(0); PG8_MMA(0, 0, At, B0); PG8_BAR; PG8_SCHED;
            PG8_LDB(B1, 1, 1); PG8_STAGE(PG8_SB(1, 0), b3, voffB);
            PG8_BAR; PG8_WAIT_L(0); PG8_MMA(0, 1, At, B1); PG8_BAR;
            PG8_LDA(At, 1, 1); PG8_STAGE(PG8_SA(1, 0), a3, voffA);
            PG8_BAR; PG8_WAIT_L(0); PG8_MMA(1, 0, At, B0); PG8_BAR; PG8_SCHED;
            PG8_STAGE(PG8_SB(1, 1), b3 + hstep, voffB);
            PG8_WAIT_V(6); PG8_BAR; PG8_MMA(1, 1, At, B1); PG8_BAR;
        }
        E(acc, cur, wr, wc, fr, fq); S.done(cur);
        if (!has_next) break;
#pragma unroll
        for (int a = 0; a < 2; ++a)
#pragma unroll
            for (int b = 0; b < 2; ++b)
#pragma unroll
                for (int m = 0; m < 4; ++m)
#pragma unroll
                    for (int n = 0; n < 2; ++n) acc[a][b][m][n] = (f32x4){0.f, 0.f, 0.f, 0.f};
        cur = nxt; cA = nA; cB = nB; ++ui;
    }
    PG8_WAIT_V(0);
    if (wr == 0) PG8_BAR;
    PG8_BAR;
#undef PG8_SA
#undef PG8_SB
#undef PG8_STAGE
#undef PG8_LDA
#undef PG8_LDB
#undef PG8_MMA
#undef PG8_WAIT_V
#undef PG8_WAIT_L
#undef PG8_BAR
#undef PG8_SCHED
}
}

typedef f32x4 AccT[2][2][4][2];

struct EpiIn {
    static constexpr bool PERM = true; static constexpr int MID_T = 0;
    bf16_t* P; float* LR; const float* COS; const float* SIN;
    DI void mid(AccT&, const pg8::Unit&, int, int, int, int) const {}
    DI void operator()(const AccT& acc, const pg8::Unit& u, int wr, int wc, int fr, int fq) const {
        const int pn = u.pn;
        const int row0 = u.pm * 256 + wr * 64 + fr;
        if (pn == 44) {
            if (wc == 0 && fq < 2) {
#pragma unroll
                for (int ai = 0; ai < 2; ++ai)
#pragma unroll
                    for (int m = 0; m < 4; ++m) { const int row = row0 + ai * 128 + m * 16; float* o = LR + (size_t)row * 16 + 8 * fq;
                        *(f32x4*)(o) = acc[ai][0][m][0]; *(f32x4*)(o + 4) = acc[ai][0][m][1]; }
            }
            return;
        }
        const bool rot = (pn >= 12 && pn < 20), isk = (pn >= 16 && pn < 20);
        const int cl = wc * 32 + 8 * fq;
        float l2g = 0.f;
        if (isk) { const int h = pn - 16; l2g = __log2f(1.0f - exp2f(-5.0f - (float)h)); }
#pragma unroll
        for (int ai = 0; ai < 2; ++ai)
#pragma unroll
            for (int m = 0; m < 4; ++m) {
                const int row = row0 + ai * 128 + m * 16;
                f32x4 v00 = acc[ai][0][m][0], v01 = acc[ai][0][m][1], v10 = acc[ai][1][m][0], v11 = acc[ai][1][m][1];
                if (rot) {
                    const int ti = row < NTP ? (row & (TP - 1)) : (TP + (row & 3));
                    const f32x4 c0 = *(const f32x4*)(COS + (size_t)ti * 128 + cl), c1 = *(const f32x4*)(COS + (size_t)ti * 128 + cl + 4);
                    const f32x4 s0 = *(const f32x4*)(SIN + (size_t)ti * 128 + cl), s1 = *(const f32x4*)(SIN + (size_t)ti * 128 + cl + 4);
                    float sc = 1.0f;
                    if (isk) { const int sp = row < NTP ? (row & (CH - 1)) : (row & 3); sc = 0.0625f * exp2f(-(float)(sp + 1) * l2g); }
                    const f32x4 a0 = (v00 * c0 - v10 * s0) * sc, a1 = (v01 * c1 - v11 * s1) * sc;
                    const f32x4 b0 = (v00 * s0 + v10 * c0) * sc, b1 = (v01 * s1 + v11 * c1) * sc;
                    v00 = a0; v01 = a1; v10 = b0; v11 = b1;
                }
                bf16_t* rowp = P + (size_t)row * PW + pn * 256 + cl;
                u32x4 w; w.x = pk2(v00[0], v00[1]); w.y = pk2(v00[2], v00[3]); w.z = pk2(v01[0], v01[1]); w.w = pk2(v01[2], v01[3]);
                *(u32x4*)(rowp) = w;
                w.x = pk2(v10[0], v10[1]); w.y = pk2(v10[2], v10[3]); w.z = pk2(v11[0], v11[1]); w.w = pk2(v11[2], v11[3]);
                *(u32x4*)(rowp + 128) = w;
            }
    }
};

struct EpiBranch {
    static constexpr bool PERM = true; static constexpr int MID_T = 16;
    const bf16_t* P; bf16_t* MRG;
    DI void mid(AccT& acc, const pg8::Unit& u, int wr, int wc, int fr, int fq) const {
        int row0 = u.pm * 256 + wr * 64 + fr, cl = u.pn * 256 + wc * 32 + 8 * fq;
        asm volatile("" : "+v"(row0), "+v"(cl));
#pragma unroll
        for (int ai = 0; ai < 2; ++ai)
#pragma unroll
            for (int m = 0; m < 4; ++m) { const int row = row0 + ai * 128 + m * 16;
#pragma unroll
                for (int bj = 0; bj < 2; ++bj) {
                    const u32x4 g = *(const u32x4*)(P + (size_t)row * PW + C_MG + cl + bj * 128);
                    const u32x4 r = *(const u32x4*)(P + (size_t)row * PW + C_MR + cl + bj * 128);
                    const unsigned gw[4] = {g.x, g.y, g.z, g.w}, rw[4] = {r.x, r.y, r.z, r.w};
#pragma unroll
                    for (int j = 0; j < 4; ++j) {
                        const float mg0 = bflo(gw[j]), mg1 = bfhi(gw[j]); float mr0 = bflo(rw[j]), mr1 = bfhi(rw[j]);
                        mr0 = fmaxf(mr0, -60.f); mr1 = fmaxf(mr1, -60.f);
                        const float q0 = (1.0f + __expf(-mr0)) / (1.0f + __expf(-mg0)), q1 = (1.0f + __expf(-mr1)) / (1.0f + __expf(-mg1));
                        acc[ai][bj][m][j >> 1][(j & 1) * 2] *= q0; acc[ai][bj][m][j >> 1][(j & 1) * 2 + 1] *= q1;
                    }
                    asm volatile("" ::: "memory");
                } }
    }
    DI void operator()(const AccT& acc, const pg8::Unit& u, int wr, int wc, int fr, int fq) const {
        const int row0 = u.pm * 256 + wr * 64 + fr, cl = u.pn * 256 + wc * 32 + 8 * fq;
#pragma unroll
        for (int ai = 0; ai < 2; ++ai)
#pragma unroll
            for (int m = 0; m < 4; ++m) { const int row = row0 + ai * 128 + m * 16;
#pragma unroll
                for (int bj = 0; bj < 2; ++bj) {
                    const u32x4 r = *(const u32x4*)(P + (size_t)row * PW + C_MR + cl + bj * 128);
                    const unsigned rw[4] = {r.x, r.y, r.z, r.w}; unsigned ow[4];
#pragma unroll
                    for (int j = 0; j < 4; ++j) {
                        const float mr0 = fmaxf(bflo(rw[j]), -60.f), mr1 = fmaxf(bfhi(rw[j]), -60.f);
                        const float o0 = acc[ai][bj][m][j >> 1][(j & 1) * 2] * sigmoidf_(mr0), o1 = acc[ai][bj][m][j >> 1][(j & 1) * 2 + 1] * sigmoidf_(mr1);
                        ow[j] = pk2(o0, o1);
                    }
                    u32x4 w; w.x = ow[0]; w.y = ow[1]; w.z = ow[2]; w.w = ow[3];
                    *(u32x4*)(MRG + (size_t)row * DM + cl + bj * 128) = w;
                } }
    }
};

struct EpiOut {
    static constexpr bool PERM = false; static constexpr int MID_T = 0;
    const float* xp; const float* xs; const float* ADA; float* Y; float* YST;
    DI void mid(AccT&, const pg8::Unit&, int, int, int, int) const {}
    DI void operator()(const AccT& acc, const pg8::Unit& u, int wr, int wc, int fr, int fq) const {
        const int row0 = u.pm * 256 + wr * 64 + fr, col0 = u.pn * 256 + wc * 32 + 4 * fq;
#pragma unroll
        for (int ai = 0; ai < 2; ++ai)
#pragma unroll
            for (int m = 0; m < 4; ++m) { const int row = row0 + ai * 128 + m * 16;
                const float* xr = row < NTP ? xp + (size_t)row * DM : xs + (size_t)(row - NTP) * DM;
                const int bidx = row < NTP ? (row >> 11) : (NB_P + ((row - NTP) >> 2));
                const float* gr = ADA + (size_t)bidx * 3072 + 2048;
#pragma unroll
                for (int bj = 0; bj < 2; ++bj)
#pragma unroll
                    for (int n = 0; n < 2; ++n) { const int c = col0 + bj * 128 + n * 16;
                        const f32x4 xv = *(const f32x4*)(xr + c), gv = *(const f32x4*)(gr + c);
                        const f32x4 v = xv * DN_ALPHA + gv * acc[ai][bj][m][n];
                        *(f32x4*)(Y + (size_t)row * DM + c) = v; }
            }
    }
};

#define XB_TMO      128
#define XB_XCNT(j)  (256  + 64 * (j))
#define XB_XSUB(j)  (1280 + 64 * (j))
#define XB_XGEN(j)  (2304 + 64 * (j))
#define XB_TOP      3328
#define XB_TOPGEN   3392
#define XCD_BAR_WORDS 3456
#define XB_SPIN_CAP (1u << 18)
DI unsigned xb_ld(unsigned* p)              { return __hip_atomic_load(p, __ATOMIC_RELAXED, __HIP_MEMORY_SCOPE_AGENT); }
DI unsigned xb_add(unsigned* p, unsigned v) { return __hip_atomic_fetch_add(p, v, __ATOMIC_RELAXED, __HIP_MEMORY_SCOPE_AGENT); }
DI unsigned xb_xcc_id() { return (unsigned)__builtin_amdgcn_s_getreg((3 << 11) | 20) & 0xFu; }
#define XB_SPIN(cond, bar) do { unsigned _sp = 0; while (cond) { __builtin_amdgcn_s_sleep(1); \
    if ((++_sp & 255u) == 0u) { if (xb_ld(&(bar)[XB_TMO])) break; if (_sp > XB_SPIN_CAP) { atomicAdd(&(bar)[XB_TMO], 1u); break; } } } } while (0)
struct XcdBarrier { unsigned* bar; unsigned x; volatile LAS unsigned* st; };
DI XcdBarrier xcd_barrier_post(unsigned* bar, volatile LAS unsigned* st) {
    XcdBarrier b; b.bar = bar; b.x = xb_xcc_id(); b.st = st;
    if (threadIdx.x == 0) (void)xb_add(&bar[XB_XCNT(b.x)], 1u);
    return b;
}
DI void xcd_barrier_complete(unsigned* bar, unsigned x, unsigned& nloc, unsigned& nx) {
    const unsigned G = gridDim.x * gridDim.y * gridDim.z;
    unsigned sum, cnt, mine, sp = 0u;
    for (;;) {
        sum = 0u; cnt = 0u; mine = 0u;
#pragma unroll
        for (unsigned j = 0; j < 16; ++j) { const unsigned c = xb_ld(&bar[XB_XCNT(j)]); sum += c; cnt += (c > 0u) ? 1u : 0u; mine = (j == x) ? c : mine; }
        if (sum == G) break;
        __builtin_amdgcn_s_sleep(1);
        if ((++sp & 255u) == 0u) { if (xb_ld(&bar[XB_TMO])) break; if (sp > XB_SPIN_CAP) { atomicAdd(&bar[XB_TMO], 1u); break; } }
    }
    nloc = mine > 0u ? mine : 1u; nx = cnt > 0u ? cnt : 1u;
}
DI void xcd_barrier(const XcdBarrier& b) {
    asm volatile("s_waitcnt vmcnt(0)" ::: "memory");
    __syncthreads();
    if (threadIdx.x == 0) {
        unsigned* bar = b.bar;
        __builtin_amdgcn_s_waitcnt(0);
        unsigned nloc = b.st[0], nx = b.st[1];
        if (nloc == 0u) { xcd_barrier_complete(bar, b.x, nloc, nx); b.st[0] = nloc; b.st[1] = nx; }
        const unsigned old = xb_add(&bar[XB_XSUB(b.x)], 1u);
        const unsigned gen = old / nloc;
        if (old + 1u == (gen + 1u) * nloc) {
            __builtin_amdgcn_fence(__ATOMIC_RELEASE, "agent");
            asm volatile("s_waitcnt vmcnt(0)" ::: "memory");
            const unsigned og = xb_add(&bar[XB_TOP], 1u);
            const unsigned tg = og / nx;
            if (og + 1u == (tg + 1u) * nx) xb_add(&bar[XB_TOPGEN], 1u);
            else XB_SPIN(xb_ld(&bar[XB_TOPGEN]) == tg, bar);
            __builtin_amdgcn_fence(__ATOMIC_ACQUIRE, "agent");
            xb_add(&bar[XB_XGEN(b.x)], 1u);
            asm volatile("s_waitcnt vmcnt(0)" ::: "memory");
        } else {
            XB_SPIN(xb_ld(&bar[XB_XGEN(b.x)]) == gen, bar);
            __builtin_amdgcn_fence(__ATOMIC_ACQUIRE, "agent");
            asm volatile("s_waitcnt vmcnt(0)" ::: "memory");
        }
    }
    __syncthreads();
}

template <int MODE>
DI void transpose_item(const float* W, int N, bf16_t* WT, int ldk, int koff, LAS float* scr, int kb, int nb, int lane) {
    const int k0 = 64 * kb, n0 = 32 * nb;
    const int n = n0 + (lane & 31);
    int src = n;
    if (MODE == 1) src = n < 3072 ? n : (n < 11264 ? n + 16 : (n < 11280 ? 3072 + (n - 11264) : -1));
    float tv[32];
#pragma unroll
    for (int i = 0; i < 32; ++i) { const int kk = 2 * i + (lane >> 5); tv[i] = src >= 0 ? W[(size_t)(k0 + kk) * N + src] : 0.f; }
#pragma unroll
    for (int i = 0; i < 32; ++i) { const int kk = 2 * i + (lane >> 5); scr[kk * 33 + (lane & 31)] = tv[i]; }
    LDS_WAIT(); asm volatile("" ::: "memory");
    const int c = lane & 7;
#pragma unroll
    for (int j = 0; j < 4; ++j) { const int nn = (lane >> 3) + 8 * j; const LAS float* s = scr + (8 * c) * 33 + nn;
        u32x4 o; o.x = pk2(s[0 * 33], s[1 * 33]); o.y = pk2(s[2 * 33], s[3 * 33]); o.z = pk2(s[4 * 33], s[5 * 33]); o.w = pk2(s[6 * 33], s[7 * 33]);
        *(u32x4*)(WT + (size_t)(n0 + nn) * ldk + koff + k0 + 8 * c) = o; }
    LDS_WAIT(); asm volatile("" ::: "memory");
}

DI void phase0(const Params& p, LAS unsigned char* lds) {
    const int tid = threadIdx.x, lane = tid & 63, wave = __builtin_amdgcn_readfirstlane(tid >> 6);
    const int G = gridDim.x, bx = blockIdx.x;
    unsigned char* ws = p.ws;
    {
        LAS float* scr = (LAS float*)(lds + wave * 16384);
        const int gw = bx * 8 + wave, NGW = G * 8;
        constexpr int I_IN = 16 * (NIN / 32), I_BG = 16 * 32, I_BR = 32 * 32, I_O = 16 * 32;
        constexpr int NIT = I_IN + I_BG + I_BR + I_O;
        for (int it = gw; it < NIT; it += NGW) {
            int r = it;
            if (r < I_IN) { transpose_item<1>(p.in[8], 11280, (bf16_t*)(ws + WS_WIN), 1024, 0, scr, r / (NIN / 32), r % (NIN / 32), lane); continue; } r -= I_IN;
            if (r < I_BG) { transpose_item<0>(p.in[13], 1024, (bf16_t*)(ws + WS_WBR), 3072, 0, scr, r / 32, r % 32, lane); continue; } r -= I_BG;
            if (r < I_BR) { transpose_item<0>(p.in[14], 1024, (bf16_t*)(ws + WS_WBR), 3072, 1024, scr, r / 32, r % 32, lane); continue; } r -= I_BR;
            transpose_item<0>(p.in[15], 1024, (bf16_t*)(ws + WS_WO), 1024, 0, scr, r / 32, r % 32, lane);
        }
    }
    {
        float* COS = (float*)(ws + WS_COS); float* SIN = (float*)(ws + WS_SIN);
        for (int i = bx * 512 + tid; i < 2052 * 128; i += G * 512) {
            const int ti = i >> 7, j = i & 127;
            const double pos = ti < TP ? (double)ti : (double)(16384 + (ti - TP));
            const double inv = exp(-(double)j * (9.210340371976184 / 128.0));
            const double ang = pos * inv;
            const double red = ang - 6.283185307179586476925 * rint(ang * 0.15915494309189533577);
            float sn, cs_; sincosf((float)red, &sn, &cs_);
            COS[i] = cs_; SIN[i] = sn;
        }
    }
    __syncthreads();
    {
        const float* wada = p.in[6]; const float* bada = p.in[7];
        float* ADA = (float*)(ws + WS_ADA);
        LAS float* cs = (LAS float*)lds;
        LAS float* red = (LAS float*)(lds + 65536);
        for (int task = bx; task < 9 * 48; task += G) {
            const int rg = task / 48, cb = task % 48, r0 = rg * 16, j0 = cb * 64;
            __syncthreads();
            for (int i = tid; i < 16 * 256; i += 512) { const int r = r0 + (i >> 8), k = (i & 255) * 4;
                f32x4 v = (f32x4){0.f, 0.f, 0.f, 0.f}; if (r < 136) v = r < NB_P ? *(const f32x4*)(p.in[4] + (size_t)r * 1024 + k) : *(const f32x4*)(p.in[5] + (size_t)(r - NB_P) * 1024 + k);
                *(LAS f32x4*)(cs + (i >> 8) * 1024 + k) = v; }
            __syncthreads();
            float a[16];
#pragma unroll
            for (int r = 0; r < 16; ++r) a[r] = 0.f;
            const int kbeg = wave * 128;
            for (int kb2 = kbeg; kb2 < kbeg + 128; kb2 += 32) {
                float wv[32];
#pragma unroll
                for (int q = 0; q < 32; ++q) wv[q] = wada[(size_t)(kb2 + q) * 3072 + j0 + lane];
#pragma unroll
                for (int q = 0; q < 32; q += 4) {
#pragma unroll
                    for (int r = 0; r < 16; ++r) { const f32x4 cv = *(const LAS f32x4*)(cs + r * 1024 + kb2 + q);
                        a[r] += cv[0] * wv[q] + cv[1] * wv[q + 1] + cv[2] * wv[q + 2] + cv[3] * wv[q + 3]; }
                    asm volatile("" ::: "memory");
                }
            }
#pragma unroll
            for (int r = 0; r < 16; ++r) red[(wave * 16 + r) * 64 + lane] = a[r];
            __syncthreads();
            for (int i = tid; i < 16 * 64; i += 512) { const int r = i >> 6, j = i & 63; float s = 0.f;
#pragma unroll
                for (int w = 0; w < 8; ++w) s += red[(w * 16 + r) * 64 + j];
                if (r0 + r < 136) ADA[(size_t)(r0 + r) * 3072 + j0 + j] = s + bada[j0 + j]; }
        }
        __syncthreads();
    }
}

DI void phase1(const Params& p) {
    const int tid = threadIdx.x, lane = tid & 63, wave = tid >> 6;
    const int gw = blockIdx.x * 8 + wave, NGW = gridDim.x * 8;
    const float* ADA = (const float*)(p.ws + WS_ADA); bf16_t* H = (bf16_t*)(p.ws + WS_H);
    for (int row = gw; row < NTOK; row += NGW) {
        const float* xr = row < NTP ? p.in[0] + (size_t)row * DM : p.in[1] + (size_t)(row - NTP) * DM;
        const int bidx = row < NTP ? (row >> 11) : (NB_P + ((row - NTP) >> 2));
        const float* ar = ADA + (size_t)bidx * 3072;
#pragma unroll
        for (int j = 0; j < 4; ++j) { const int c = 4 * lane + 256 * j;
            const f32x4 xv = *(const f32x4*)(xr + c), sh = *(const f32x4*)(ar + c), sc = *(const f32x4*)(ar + 1024 + c);
            const f32x4 hv = xv * (sc + 1.0f) + sh;
            u32x2 w; w.x = pk2(hv[0], hv[1]); w.y = pk2(hv[2], hv[3]);
            *(u32x2*)(H + (size_t)row * DM + c) = w; }
    }
}

DI void phase3(const Params& p, LAS unsigned char* lds) {
    const int tid = threadIdx.x;
    bf16_t* P = (bf16_t*)(p.ws + WS_P); const float* LR = (const float*)(p.ws + WS_LR); float* LAM = (float*)(p.ws + WS_LAM);
    const float* wl = p.in[9]; const float* bl = p.in[10];
    LAS float* lrs = (LAS float*)lds;
    LAS float* ebuf = (LAS float*)(lds + 4096);
    float w[16];
#pragma unroll
    for (int j = 0; j < 16; ++j) w[j] = wl[j * 512 + tid];
    const float bias = bl[tid];
    for (int item = blockIdx.x; item < NCHP + NB_S; item += gridDim.x) {
        const int tok0 = item < NCHP ? item * CH : NTP + (item - NCHP) * 4;
        const int nt = item < NCHP ? CH : 4;
        __syncthreads();
        for (int i = tid; i < nt * 16; i += 512) lrs[i] = LR[(size_t)tok0 * 16 + i];
        __syncthreads();
        float bc = 0.f;
        for (int t = 0; t < nt; ++t) {
            float x = bias;
#pragma unroll
            for (int j = 0; j < 16; j += 4) { const f32x4 l4 = *(const LAS f32x4*)(lrs + t * 16 + j); x += l4[0] * w[j] + l4[1] * w[j + 1] + l4[2] * w[j + 2] + l4[3] * w[j + 3]; }
            const float ls = fminf(x, 0.f) - log1pf(expf(-fabsf(x)));
            bc += ls * 0.0625f;
            ebuf[t * 512 + tid] = expf(bc);
        }
        LAM[(size_t)item * 512 + tid] = expf(bc);
        __syncthreads();
        for (int it = tid; it < nt * 64; it += 512) {
            const int t = it >> 6, c8 = (it & 63) * 8;
            bf16_t* pr = P + (size_t)(tok0 + t) * PW;
            const u32x4 qv = *(const u32x4*)(pr + C_QG + c8), kv = *(const u32x4*)(pr + C_KG + c8);
            const f32x4 e0 = *(const LAS f32x4*)(ebuf + t * 512 + c8), e1 = *(const LAS f32x4*)(ebuf + t * 512 + c8 + 4);
            const float ev[8] = {e0[0], e0[1], e0[2], e0[3], e1[0], e1[1], e1[2], e1[3]};
            const unsigned qw[4] = {qv.x, qv.y, qv.z, qv.w}, kw[4] = {kv.x, kv.y, kv.z, kv.w}; unsigned qo[4], ko[4];
#pragma unroll
            for (int j = 0; j < 4; ++j) {
                const float ea = ev[2 * j], eb = ev[2 * j + 1];
                qo[j] = pk2(bflo(qw[j]) * ea * 0.08838834764831845f, bfhi(qw[j]) * eb * 0.08838834764831845f);
                ko[j] = pk2(bflo(kw[j]) / ea, bfhi(kw[j]) / eb);
            }
            u32x4 o; o.x = qo[0]; o.y = qo[1]; o.z = qo[2]; o.w = qo[3]; *(u32x4*)(pr + C_QG + c8) = o;
            o.x = ko[0]; o.y = ko[1]; o.z = ko[2]; o.w = ko[3]; *(u32x4*)(pr + C_KG + c8) = o;
        }
    }
}

template <int RS> DI int imgaddr(int row, int col) {
    const int swz = RS == 128 ? ((row >> 1) & 7) : (row & 15);
    return row * RS + ((((col >> 3) ^ swz)) << 4) + ((col & 7) << 1);
}
template <int RS> DI bf16x8 frag(const LAS unsigned char* base, int rb, int ks, int lane) {
    return *(const LAS bf16x8*)(base + imgaddr<RS>(16 * rb + (lane & 15), 32 * ks + 8 * (lane >> 4)));
}
#define MFMA16(a, b, c) __builtin_amdgcn_mfma_f32_16x16x32_bf16((a), (b), (c), 0, 0, 0)

template <int DK, bool RET>
DI void prompt_task(const Params& p, LAS unsigned char* lds, int b, int h, int slice) {
    constexpr int RSQ = DK * 2;
    constexpr int OFF_Q = 0, OFF_K = 64 * RSQ, OFF_KT = 2 * 64 * RSQ, OFF_VT = OFF_KT + DK * 128, OFF_P = OFF_VT + 8192, OFF_S = OFF_P + 8192;
    constexpr int CPR = DK / 8;
    constexpr int NQ = 64 * CPR / 512;
    constexpr int NDB = DK / 128;
    constexpr int DV = RET ? 512 : 256;
    const int tid = threadIdx.x, lane = tid & 63, w = __builtin_amdgcn_readfirstlane(tid >> 6), r = lane & 15, g = lane >> 4;
    const bf16_t* P = (const bf16_t*)(p.ws + WS_P);
    bf16_t* O = (bf16_t*)(p.ws + WS_O); float* STAT = (float*)(p.ws + WS_STAT); const float* LAM = (const float*)(p.ws + WS_LAM);
    const int colQ = (RET ? C_QR : C_QG) + h * DK, colK = (RET ? C_KR : C_KG) + h * DK, colV = (RET ? C_VR : C_VG) + h * DV + slice * 64;
    const int ocol = (RET ? 1024 : 0) + h * DV + slice * 64;
    const int headidx = RET ? 4 + h : h;
    const float l2g = RET ? __log2f(1.0f - exp2f(-5.0f - (float)h)) : 0.f;
    const float gC = RET ? exp2f((float)CH * l2g) : 1.f;

    f32x4 accS[NDB][4];
#pragma unroll
    for (int j = 0; j < NDB; ++j)
#pragma unroll
        for (int v = 0; v < 4; ++v) accS[j][v] = (f32x4){0.f, 0.f, 0.f, 0.f};
    __syncthreads();
    for (int i = tid; i < 64 * RSQ / 16; i += 512) *(LAS u32x4*)(lds + OFF_S + i * 16) = (u32x4){0u, 0u, 0u, 0u};

    constexpr int NKI = 32 * CPR / 512;
    u32x4 rq[NQ], rk[NKI][2], rv[2];
    unsigned pfv = 0u, pfacc = 0u;
    const int vsp = tid & 31, vch = tid >> 5;
    rv[0] = (u32x4){0u, 0u, 0u, 0u}; rv[1] = rv[0];
    {
        const size_t tok0 = (size_t)b * TP;
#pragma unroll
        for (int i = 0; i < NQ; ++i) { const int id = tid + 512 * i, row = id / CPR, ch = id % CPR; rq[i] = *(const u32x4*)(P + (tok0 + row) * PW + colQ + ch * 8); }
#pragma unroll
        for (int j = 0; j < NKI; ++j) { const int id = tid + 512 * j, sp = id & 31, ch = id >> 5;
            rk[j][0] = *(const u32x4*)(P + (tok0 + 2 * sp) * PW + colK + ch * 8); rk[j][1] = *(const u32x4*)(P + (tok0 + 2 * sp + 1) * PW + colK + ch * 8); }
        if (tid < 256) { rv[0] = *(const u32x4*)(P + (tok0 + 2 * vsp) * PW + colV + vch * 8); rv[1] = *(const u32x4*)(P + (tok0 + 2 * vsp + 1) * PW + colV + vch * 8); }
    }
    for (int c = 0; c < TP / CH; ++c) {
        const size_t tok0 = (size_t)b * TP + (size_t)c * CH;
#pragma unroll
        for (int i = 0; i < NQ; ++i) { const int id = tid + 512 * i, row = id / CPR, ch = id % CPR; *(LAS u32x4*)(lds + OFF_Q + imgaddr<RSQ>(row, ch * 8)) = rq[i]; }
#pragma unroll
        for (int j = 0; j < NKI; ++j) { const int id = tid + 512 * j, sp = id & 31, ch = id >> 5;
            *(LAS u32x4*)(lds + OFF_K + imgaddr<RSQ>(2 * sp, ch * 8)) = rk[j][0];
            *(LAS u32x4*)(lds + OFF_K + imgaddr<RSQ>(2 * sp + 1, ch * 8)) = rk[j][1];
            const unsigned k0[4] = {rk[j][0].x, rk[j][0].y, rk[j][0].z, rk[j][0].w}, k1[4] = {rk[j][1].x, rk[j][1].y, rk[j][1].z, rk[j][1].w};
#pragma unroll
            for (int e = 0; e < 8; ++e) { const unsigned lo = (k0[e >> 1] >> ((e & 1) * 16)) & 0xffffu, hi = (k1[e >> 1] >> ((e & 1) * 16)) & 0xffffu;
                *(LAS unsigned*)(lds + OFF_KT + imgaddr<128>(ch * 8 + e, 2 * sp)) = lo | (hi << 16); }
        }
        if (tid < 256) { const unsigned v0[4] = {rv[0].x, rv[0].y, rv[0].z, rv[0].w}, v1[4] = {rv[1].x, rv[1].y, rv[1].z, rv[1].w};
#pragma unroll
            for (int e = 0; e < 8; ++e) { const unsigned lo = (v0[e >> 1] >> ((e & 1) * 16)) & 0xffffu, hi = (v1[e >> 1] >> ((e & 1) * 16)) & 0xffffu;
                *(LAS unsigned*)(lds + OFF_VT + imgaddr<128>(vch * 8 + e, 2 * vsp)) = lo | (hi << 16); } }
        __syncthreads();
        pfacc ^= pfv;
        if (c + 2 < TP / CH) {
            const size_t t2 = tok0 + 2 * CH;
            constexpr int NSL = RET ? 8 : 4, LPR = DK / 64  , NLN = 2 * 64 * LPR / NSL  ;
            if (tid < NLN) { const int line = tid * NSL + slice, which = line / (64 * LPR), row = (line % (64 * LPR)) / LPR, seg = line % LPR;
                pfv = *(const unsigned*)(P + (t2 + row) * PW + (which ? colK : colQ) + seg * 64); }
            else if (tid >= 256 && tid < 320) pfv = *(const unsigned*)(P + (t2 + (tid - 256)) * PW + colV);
        }
        if (c + 1 < TP / CH) {
            const size_t tn = tok0 + CH;
#pragma unroll
            for (int i = 0; i < NQ; ++i) { const int id = tid + 512 * i, row = id / CPR, ch = id % CPR; rq[i] = *(const u32x4*)(P + (tn + row) * PW + colQ + ch * 8); }
#pragma unroll
            for (int j = 0; j < NKI; ++j) { const int id = tid + 512 * j, sp = id & 31, ch = id >> 5;
                rk[j][0] = *(const u32x4*)(P + (tn + 2 * sp) * PW + colK + ch * 8); rk[j][1] = *(const u32x4*)(P + (tn + 2 * sp + 1) * PW + colK + ch * 8); }
            if (tid < 256) { rv[0] = *(const u32x4*)(P + (tn + 2 * vsp) * PW + colV + vch * 8); rv[1] = *(const u32x4*)(P + (tn + 2 * vsp + 1) * PW + colV + vch * 8); }
        }
        {
            const int tb = w & 3, sh = w >> 2;
            f32x4 a1[2]; a1[0] = (f32x4){0.f, 0.f, 0.f, 0.f}; a1[1] = a1[0];
            if (!(sh == 1 && tb < 2)) {
#pragma unroll 4
                for (int ks = 0; ks < DK / 32; ++ks) {
                    const bf16x8 qB = frag<RSQ>(lds + OFF_Q, tb, ks, lane);
                    const bf16x8 k0 = frag<RSQ>(lds + OFF_K, 2 * sh, ks, lane), k1 = frag<RSQ>(lds + OFF_K, 2 * sh + 1, ks, lane);
                    a1[0] = MFMA16(k0, qB, a1[0]); a1[1] = MFMA16(k1, qB, a1[1]);
                }
            }
#pragma unroll
            for (int i = 0; i < 2; ++i) { const int t = 16 * tb + r, s0 = 16 * (2 * sh + i) + 4 * g;
                const float e0 = (s0 + 0 <= t) ? a1[i][0] : 0.f, e1 = (s0 + 1 <= t) ? a1[i][1] : 0.f, e2 = (s0 + 2 <= t) ? a1[i][2] : 0.f, e3 = (s0 + 3 <= t) ? a1[i][3] : 0.f;
                u32x2 pw; pw.x = pk2(e0, e1); pw.y = pk2(e2, e3);
                *(LAS u32x2*)(lds + OFF_P + imgaddr<128>(t, s0)) = pw; }
        }
        __syncthreads();
        {
            const int tb = w & 3, vb0 = 2 * (w >> 2);
            f32x4 a2[2]; a2[0] = (f32x4){0.f, 0.f, 0.f, 0.f}; a2[1] = a2[0];
#pragma unroll
            for (int ks = 0; ks < 2; ++ks) {
                const bf16x8 pB = frag<128>(lds + OFF_P, tb, ks, lane);
#pragma unroll
                for (int i = 0; i < 2; ++i) { const bf16x8 vA = frag<128>(lds + OFF_VT, vb0 + i, ks, lane); a2[i] = MFMA16(vA, pB, a2[i]); }
            }
#pragma unroll 4
            for (int ks = 0; ks < DK / 32; ++ks) {
                const bf16x8 qB = frag<RSQ>(lds + OFF_Q, tb, ks, lane);
#pragma unroll
                for (int i = 0; i < 2; ++i) { const bf16x8 sA = frag<RSQ>(lds + OFF_S, vb0 + i, ks, lane); a2[i] = MFMA16(sA, qB, a2[i]); }
            }
            const int tl = 16 * tb + r; const size_t token = tok0 + tl;
            const float sc = RET ? exp2f((float)(tl + 1) * l2g) : 1.f;
            float s1 = 0.f, s2 = 0.f;
#pragma unroll
            for (int i = 0; i < 2; ++i) { a2[i] = a2[i] * sc;
                s1 += (a2[i][0] + a2[i][1]) + (a2[i][2] + a2[i][3]);
                s2 += (a2[i][0] * a2[i][0] + a2[i][1] * a2[i][1]) + (a2[i][2] * a2[i][2] + a2[i][3] * a2[i][3]);
                u32x2 ow; ow.x = pk2(a2[i][0], a2[i][1]); ow.y = pk2(a2[i][2], a2[i][3]);
                *(u32x2*)(O + token * UW + ocol + 16 * (vb0 + i) + 4 * g) = ow; }
            s1 += __shfl_xor(s1, 16); s1 += __shfl_xor(s1, 32); s2 += __shfl_xor(s2, 16); s2 += __shfl_xor(s2, 32);
            if (g == 0) { float* so = STAT + ((token * 8 + headidx) * 16 + slice * 2 + (w >> 2)) * 2; so[0] = s1; so[1] = s2; }
        }
        {
#pragma unroll
            for (int ks = 0; ks < 2; ++ks) {
                bf16x8 vB[4];
#pragma unroll
                for (int v = 0; v < 4; ++v) vB[v] = frag<128>(lds + OFF_VT, v, ks, lane);
#pragma unroll
                for (int j = 0; j < NDB; ++j) { const bf16x8 kA = frag<128>(lds + OFF_KT, w * NDB + j, ks, lane);
#pragma unroll
                    for (int v = 0; v < 4; ++v) accS[j][v] = MFMA16(kA, vB[v], accS[j][v]); }
            }
#pragma unroll
            for (int j = 0; j < NDB; ++j) {
                f32x4 lam;
                if (RET) lam = (f32x4){gC, gC, gC, gC};
                else lam = *(const f32x4*)(LAM + (size_t)(b * (TP / CH) + c) * 512 + h * 128 + 16 * (w * NDB + j) + 4 * g);
#pragma unroll
                for (int v = 0; v < 4; ++v) accS[j][v] = accS[j][v] * lam;
            }
        }
        __syncthreads();
#pragma unroll
        for (int j = 0; j < NDB; ++j)
#pragma unroll
            for (int v = 0; v < 4; ++v) { u32x2 sw; sw.x = pk2(accS[j][v][0], accS[j][v][1]); sw.y = pk2(accS[j][v][2], accS[j][v][3]);
                *(LAS u32x2*)(lds + OFF_S + imgaddr<RSQ>(16 * v + r, 16 * (w * NDB + j) + 4 * g)) = sw; }
    }
    pfacc ^= pfv;
    if (pfacc == 0x9e3779b9u) ((unsigned*)(p.ws + WS_CTL))[8] = pfacc;
    float* So = p.out + (RET ? OUT_SRP : OUT_SGP) + ((size_t)(b * 4 + h) * DK) * DV + slice * 64;
#pragma unroll
    for (int j = 0; j < NDB; ++j)
#pragma unroll
        for (int v = 0; v < 4; ++v)
#pragma unroll
            for (int e = 0; e < 4; ++e) So[(size_t)(16 * (w * NDB + j) + 4 * g + e) * DV + 16 * v + r] = accS[j][v][e];
}

template <int DK, bool RET>
DI void sample_task(const Params& p, LAS unsigned char* lds, int b, int h) {
    constexpr int DV = RET ? 512 : 256;
    constexpr int NCG = DV / 4;
    constexpr int NRG = 512 / NCG;
    constexpr int RPT = DK / NRG;
    const int tid = threadIdx.x, lane = tid & 63, w = tid >> 6;
    const bf16_t* P = (const bf16_t*)(p.ws + WS_P); bf16_t* U = (bf16_t*)(p.ws + WS_U); const float* LAM = (const float*)(p.ws + WS_LAM);
    const int colQ = (RET ? C_QR : C_QG) + h * DK, colK = (RET ? C_KR : C_KG) + h * DK, colV = (RET ? C_VR : C_VG) + h * DV, colZ = (RET ? C_ZR : C_ZG) + h * DV;
    const int ucol = (RET ? 1024 : 0) + h * DV;
    const size_t tok0 = (size_t)NTP + (size_t)b * 4;
    const float l2g = RET ? __log2f(1.0f - exp2f(-5.0f - (float)h)) : 0.f;
    LAS float* qs = (LAS float*)lds;
    LAS float* ks = qs + 4 * DK;
    LAS float* lam = ks + 4 * DK;
    LAS float* am = lam + DK;
    LAS float* st = am + 16;
    LAS float* red = (LAS float*)(lds + 16384);
    __syncthreads();
    for (int i = tid; i < 4 * DK; i += 512) { const int t = i / DK, d = i % DK;
        qs[i] = bf1(P[(tok0 + t) * PW + colQ + d]); ks[i] = bf1(P[(tok0 + t) * PW + colK + d]); }
    for (int i = tid; i < DK; i += 512) lam[i] = RET ? exp2f(4.0f * l2g) : LAM[(size_t)(NCHP + b) * 512 + h * 128 + i];
    __syncthreads();
    for (int pr = w; pr < 16; pr += 8) { const int t = pr >> 2, s = pr & 3; float a = 0.f;
        for (int d = lane; d < DK; d += 64) a += qs[t * DK + d] * ks[s * DK + d];
        a = wave_sum(a); if (lane == 0) am[pr] = (s <= t) ? a : 0.f; }
    const int cg = tid % NCG, rg = tid / NCG;
    f32x4 vv[4], oo[4];
#pragma unroll
    for (int t = 0; t < 4; ++t) { const u32x2 x = *(const u32x2*)(P + (tok0 + t) * PW + colV + 4 * cg);
        vv[t] = (f32x4){bflo(x.x), bfhi(x.x), bflo(x.y), bfhi(x.y)}; oo[t] = (f32x4){0.f, 0.f, 0.f, 0.f}; }
    const float* S0 = p.in[RET ? 3 : 2] + ((size_t)(b * 4 + h) * DK) * DV + 4 * cg;
    float* S1 = p.out + (RET ? OUT_SRS : OUT_SGS) + ((size_t)(b * 4 + h) * DK) * DV + 4 * cg;
#pragma unroll 8
    for (int i = 0; i < RPT; ++i) {
        const int d = rg + NRG * i;
        const f32x4 s0 = *(const f32x4*)(S0 + (size_t)d * DV);
        f32x4 n = s0;
#pragma unroll
        for (int t = 0; t < 4; ++t) { n += vv[t] * ks[t * DK + d]; oo[t] += s0 * qs[t * DK + d]; }
        *(f32x4*)(S1 + (size_t)d * DV) = n * lam[d];
    }
#pragma unroll
    for (int t = 0; t < 4; ++t) *(LAS f32x4*)(red + ((rg * 4 + t) * DV + 4 * cg)) = oo[t];
    __syncthreads();
    const int ft = tid / NCG, fcg = tid % NCG; const bool fin = tid < 4 * NCG;
    f32x4 o = (f32x4){0.f, 0.f, 0.f, 0.f};
    if (fin) {
#pragma unroll
        for (int q = 0; q < NRG; ++q) o += *(const LAS f32x4*)(red + ((q * 4 + ft) * DV + 4 * fcg));
#pragma unroll
        for (int s = 0; s < 4; ++s) o += vv[s] * am[ft * 4 + s];
        if (RET) o = o * exp2f((float)(ft + 1) * l2g);
        float s1 = (o[0] + o[1]) + (o[2] + o[3]), s2 = (o[0] * o[0] + o[1] * o[1]) + (o[2] * o[2] + o[3] * o[3]);
        s1 = wave_sum(s1); s2 = wave_sum(s2);
        if (lane == 0) { st[w * 2] = s1; st[w * 2 + 1] = s2; }
    }
    __syncthreads();
    if (fin) {
        constexpr int WPT = NCG / 64;
        float s1 = 0.f, s2 = 0.f;
#pragma unroll
        for (int q = 0; q < WPT; ++q) { s1 += st[(ft * WPT + q) * 2]; s2 += st[(ft * WPT + q) * 2 + 1]; }
        float mu = 0.f, rstd;
        if (RET) { mu = s1 * (1.0f / DV); rstd = rsqrtf(fmaxf(s2 * (1.0f / DV) - mu * mu, 0.f) + HN_EPS); }
        else rstd = rsqrtf(s2 * (1.0f / DV) + HN_EPS);
        const float* gn = p.in[RET ? 12 : 11] + h * DV + 4 * fcg;
        const f32x4 gv = *(const f32x4*)gn;
        const u32x2 zx = *(const u32x2*)(P + (tok0 + ft) * PW + colZ + 4 * fcg);
        const f32x4 z = (f32x4){bflo(zx.x), bfhi(zx.x), bflo(zx.y), bfhi(zx.y)};
        f32x4 u;
#pragma unroll
        for (int e = 0; e < 4; ++e) u[e] = (o[e] - mu) * rstd * gv[e] * siluf_(z[e]);
        u32x2 uw; uw.x = pk2(u[0], u[1]); uw.y = pk2(u[2], u[3]);
        *(u32x2*)(U + (tok0 + ft) * UW + ucol + 4 * fcg) = uw;
    }
}

#ifndef SQUOTA
#define SQUOTA 6
#endif
DI void phase4(const Params& p, LAS unsigned char* lds) {
    const int bx = blockIdx.x;
    volatile LAS unsigned* MISC = (volatile LAS unsigned*)(lds + LDS_MISC);
#ifndef REP4
#define REP4 0
#endif
    unsigned* qctr = (unsigned*)(p.ws + WS_CTL) + 64;
#define SAMPLE_PULL(quota) do { for (int _n = 0; _n < (quota); ++_n) { \
        __syncthreads(); \
        if (threadIdx.x == 0) MISC[4] = __hip_atomic_fetch_add(qctr, 1u, __ATOMIC_RELAXED, __HIP_MEMORY_SCOPE_AGENT); \
        __syncthreads(); \
        const int _t = (int)MISC[4]; \
        if (_t >= 1024) break; \
        if (_t < 512) sample_task<256, true>(p, lds, _t >> 2, _t & 3); \
        else sample_task<128, false>(p, lds, (_t - 512) >> 2, _t & 3); } } while (0)
    if (gridDim.x == 256) {
        const int xcd = bx & 7, i = bx >> 3;
        const int grp = xcd * 4 + (i >> 3);
        const int gt = (xcd & 3) * 32 + i;
        if (xcd < 4) {
            prompt_task<256, true>(p, lds, grp >> 2, grp & 3, i & 7);
            prompt_task<128, false>(p, lds, gt >> 4, (gt >> 2) & 3, gt & 3);
            SAMPLE_PULL(1024);
        } else {
            SAMPLE_PULL(SQUOTA);
            prompt_task<256, true>(p, lds, grp >> 2, grp & 3, i & 7);
            SAMPLE_PULL(1024);
        }
    } else {
        for (int t = bx; t < 256; t += gridDim.x) prompt_task<256, true>(p, lds, t >> 5, (t >> 3) & 3, t & 7);
        for (int t = bx; t < 128; t += gridDim.x) prompt_task<128, false>(p, lds, t >> 4, (t >> 2) & 3, t & 3);
        SAMPLE_PULL(1024);
    }
}

template <int K, int KB  >
DI void tail_mma(const bf16_t* __restrict__ Arow, const bf16_t* __restrict__ Wrow, f32x4& acc) {
    for (int k0 = 0; k0 < K; k0 += 32 * KB) {
        bf16x8 a[KB], w[KB];
#pragma unroll
        for (int j = 0; j < KB; ++j) { a[j] = *(const bf16x8*)(Arow + k0 + 32 * j); w[j] = *(const bf16x8*)(Wrow + k0 + 32 * j); }
#pragma unroll
        for (int j = 0; j < KB; ++j) acc = MFMA16(w[j], a[j], acc);
    }
}
DI void tail_branch(const Params& p) {
    const int lane = threadIdx.x & 63, r = lane & 15, g = lane >> 4;
    const int gw = blockIdx.x * 8 + (threadIdx.x >> 6), NGW = gridDim.x * 8;
    const bf16_t* U = (const bf16_t*)(p.ws + WS_U); const bf16_t* W = (const bf16_t*)(p.ws + WS_WBR); const bf16_t* P = (const bf16_t*)(p.ws + WS_P); bf16_t* MRG = (bf16_t*)(p.ws + WS_MRG);
    for (int tile = gw; tile < 32 * 64; tile += NGW) {
        const int t0 = NTP + (tile >> 6) * 16, n0 = (tile & 63) * 16;
        const bf16_t* Ar = U + (size_t)(t0 + r) * UW + 8 * g; const bf16_t* Wr = W + (size_t)(n0 + r) * UW + 8 * g;
        f32x4 acc = (f32x4){0.f, 0.f, 0.f, 0.f};
        tail_mma<1024, 8>(Ar, Wr, acc);
        const u32x2 gq = *(const u32x2*)(P + (size_t)(t0 + r) * PW + C_MG + n0 + 4 * g), rq = *(const u32x2*)(P + (size_t)(t0 + r) * PW + C_MR + n0 + 4 * g);
        const float mg[4] = {bflo(gq.x), bfhi(gq.x), bflo(gq.y), bfhi(gq.y)};
        float mr[4] = {bflo(rq.x), bfhi(rq.x), bflo(rq.y), bfhi(rq.y)};
#pragma unroll
        for (int e = 0; e < 4; ++e) { mr[e] = fmaxf(mr[e], -60.f); acc[e] *= (1.0f + __expf(-mr[e])) / (1.0f + __expf(-mg[e])); }
        tail_mma<2048, 8>(Ar + 1024, Wr + 1024, acc);
        u32x2 o; o.x = pk2(acc[0] * sigmoidf_(mr[0]), acc[1] * sigmoidf_(mr[1])); o.y = pk2(acc[2] * sigmoidf_(mr[2]), acc[3] * sigmoidf_(mr[3]));
        *(u32x2*)(MRG + (size_t)(t0 + r) * DM + n0 + 4 * g) = o;
    }
}
DI void tail_out(const Params& p) {
    const int lane = threadIdx.x & 63, r = lane & 15, g = lane >> 4;
    const int gw = blockIdx.x * 8 + (threadIdx.x >> 6), NGW = gridDim.x * 8;
    const bf16_t* A = (const bf16_t*)(p.ws + WS_MRG); const bf16_t* W = (const bf16_t*)(p.ws + WS_WO); const float* ADA = (const float*)(p.ws + WS_ADA);
    float* Y = p.out + OUT_Y;
    for (int tile = gw; tile < 32 * 64; tile += NGW) {
        const int t0 = NTP + (tile >> 6) * 16, n0 = (tile & 63) * 16;
        const int row = t0 + r;
        const bf16_t* Ar = A + (size_t)row * DM + 8 * g; const bf16_t* Wr = W + (size_t)(n0 + r) * DM + 8 * g;
        f32x4 acc = (f32x4){0.f, 0.f, 0.f, 0.f};
        tail_mma<1024, 8>(Ar, Wr, acc);
        const int c = n0 + 4 * g;
        const f32x4 xv = *(const f32x4*)(p.in[1] + (size_t)(row - NTP) * DM + c);
        const f32x4 gv = *(const f32x4*)(ADA + (size_t)(NB_P + ((row - NTP) >> 2)) * 3072 + 2048 + c);
        *(f32x4*)(Y + (size_t)row * DM + c) = xv * DN_ALPHA + gv * acc;
    }
}

DI void phase5(const Params& p) {
    const int tid = threadIdx.x, lane = tid & 63, wave = tid >> 6;
    const int gw = blockIdx.x * 8 + wave, NGW = gridDim.x * 8;
    const bf16_t* P = (const bf16_t*)(p.ws + WS_P); const bf16_t* O = (const bf16_t*)(p.ws + WS_O); bf16_t* U = (bf16_t*)(p.ws + WS_U);
    const float* STAT = (const float*)(p.ws + WS_STAT);
    for (int row = gw; row < NTP; row += NGW) {
        u32x4 ovv[6], zvv[6];
#pragma unroll
        for (int j = 0; j < 6; ++j) { const int c = 8 * lane + 512 * j;
            ovv[j] = *(const u32x4*)(O + (size_t)row * UW + c);
            zvv[j] = *(const u32x4*)(P + (size_t)row * PW + (c < 1024 ? C_ZG + c : C_ZR + (c - 1024))); }
        float mu, rstd;
        {
            const f32x4 sv = *(const f32x4*)(STAT + (size_t)row * 256 + lane * 4);
            float s1 = sv[0] + sv[2], s2 = sv[1] + sv[3];
            if (lane < 32 && (lane & 7) >= 4) { s1 = 0.f; s2 = 0.f; }
            s1 += __shfl_xor(s1, 1); s2 += __shfl_xor(s2, 1); s1 += __shfl_xor(s1, 2); s2 += __shfl_xor(s2, 2); s1 += __shfl_xor(s1, 4); s2 += __shfl_xor(s2, 4);
            if (lane < 32) { mu = 0.f; rstd = rsqrtf(s2 * (1.0f / 256.f) + HN_EPS); }
            else { mu = s1 * (1.0f / 512.f); rstd = rsqrtf(fmaxf(s2 * (1.0f / 512.f) - mu * mu, 0.f) + HN_EPS); }
        }
#pragma unroll
        for (int j = 0; j < 6; ++j) {
            const int c = 8 * lane + 512 * j;
            const int hd = c < 1024 ? (c >> 8) : 4 + ((c - 1024) >> 9);
            const float m = __shfl(mu, hd * 8), rs = __shfl(rstd, hd * 8);
            const u32x4 ov = ovv[j], zv = zvv[j];
            const float* gp = c < 1024 ? p.in[11] + c : p.in[12] + (c - 1024);
            const f32x4 g0 = *(const f32x4*)gp, g1 = *(const f32x4*)(gp + 4);
            const unsigned ow[4] = {ov.x, ov.y, ov.z, ov.w}, zw[4] = {zv.x, zv.y, zv.z, zv.w}; unsigned uw[4];
#pragma unroll
            for (int q = 0; q < 4; ++q) {
                const float ga = q < 2 ? g0[2 * q] : g1[2 * q - 4], gb = q < 2 ? g0[2 * q + 1] : g1[2 * q - 3];
                const float a = (bflo(ow[q]) - m) * rs * ga * siluf_(bflo(zw[q])), bb = (bfhi(ow[q]) - m) * rs * gb * siluf_(bfhi(zw[q]));
                uw[q] = pk2(a, bb);
            }
            u32x4 o; o.x = uw[0]; o.y = uw[1]; o.z = uw[2]; o.w = uw[3];
            *(u32x4*)(U + (size_t)row * UW + c) = o;
        }
    }
}

DI void phase8(const Params& p) {
    const int tid = threadIdx.x, lane = tid & 63, wave = tid >> 6;
    const int gw = blockIdx.x * 8 + wave, NGW = gridDim.x * 8;
    float* Y = p.out + OUT_Y; const float* YST = (const float*)(p.ws + WS_YST);
    const float* lg = p.in[16]; const float* lb = p.in[17];
    f32x4 gv[4], bv[4];
#pragma unroll
    for (int j = 0; j < 4; ++j) { const int c = 4 * lane + 256 * j; gv[j] = *(const f32x4*)(lg + c); bv[j] = *(const f32x4*)(lb + c); }
    for (int row = gw; row < NTOK; row += NGW) {
        f32x4 v[4];
#pragma unroll
        for (int j = 0; j < 4; ++j) v[j] = *(const f32x4*)(Y + (size_t)row * DM + 4 * lane + 256 * j);
        float s1 = 0.f;
#pragma unroll
        for (int j = 0; j < 4; ++j) s1 += (v[j][0] + v[j][1]) + (v[j][2] + v[j][3]);
        const float mean = wave_sum(s1) * (1.0f / DM); float s2 = 0.f;
#pragma unroll
        for (int j = 0; j < 4; ++j) { v[j] = v[j] - mean; s2 += (v[j][0] * v[j][0] + v[j][1] * v[j][1]) + (v[j][2] * v[j][2] + v[j][3] * v[j][3]); }
        const float rstd = rsqrtf(wave_sum(s2) * (1.0f / DM) + LN_EPS);
#pragma unroll
        for (int j = 0; j < 4; ++j) *(f32x4*)(Y + (size_t)row * DM + 4 * lane + 256 * j) = v[j] * rstd * gv[j] + bv[j];
    }
}

constexpr int NPHASE = 9;
__global__ void __launch_bounds__(512, 2) fwd_kernel(Params p) {
    extern __shared__ __attribute__((aligned(16))) unsigned char lds_raw[];
    LAS unsigned char* lds = (LAS unsigned char*)lds_raw;
    volatile LAS unsigned* MISC = (volatile LAS unsigned*)(lds + LDS_MISC);
    const int tid = threadIdx.x;
    for (int u = tid; u < (LDS_BYTES - LDS_MISC) / 4; u += 512) ((LAS unsigned*)(lds + LDS_MISC))[u] = 0u;
    __syncthreads();
    const int lo = p.ph_lo, hi = p.ph_hi;
    XcdBarrier bar; bar.bar = (unsigned*)(p.ws + WS_CTL) + CW_BAR; bar.x = 0; bar.st = nullptr;
    if (hi - lo > 1) bar = xcd_barrier_post((unsigned*)(p.ws + WS_CTL) + CW_BAR, MISC + 8);
#ifndef PHMASK
#define PHMASK 0x1ff
#endif
#define IN(k) (((PHMASK >> (k)) & 1) && lo <= (k) && (k) < hi)
#define SEAM(k) do { if (IN(k) && IN((k) + 1)) xcd_barrier(bar); } while (0)
    unsigned char* ws = p.ws;
#ifndef REPMASK
#define REPMASK 0
#endif
#define REP(k) ((REPMASK >> (k)) & 1)
#define P2BODY do { pg8::Gemm g{(const bf16_t*)(ws + WS_H), (const bf16_t*)(ws + WS_WIN), NTOK, NIN, DM}; \
        pg8::StaticOrder S; S.init(NTOK, NIN, gridDim.x, blockIdx.x); \
        EpiIn E{(bf16_t*)(ws + WS_P), (float*)(ws + WS_LR), (const float*)(ws + WS_COS), (const float*)(ws + WS_SIN)}; \
        pg8::gemm_phase<EpiIn, pg8::StaticOrder>(lds, g, S, E); } while (0)
#define P6BODY do { tail_branch(p); pg8::Gemm g{(const bf16_t*)(ws + WS_U), (const bf16_t*)(ws + WS_WBR), NTP, DM, UW}; \
        pg8::StaticOrder S; S.init(NTP, DM, gridDim.x, blockIdx.x); \
        EpiBranch E{(const bf16_t*)(ws + WS_P), (bf16_t*)(ws + WS_MRG)}; \
        pg8::gemm_phase<EpiBranch, pg8::StaticOrder>(lds, g, S, E); } while (0)
#define P7BODY do { tail_out(p); pg8::Gemm g{(const bf16_t*)(ws + WS_MRG), (const bf16_t*)(ws + WS_WO), NTP, DM, DM}; \
        pg8::StaticOrder S; S.init(NTP, DM, gridDim.x, blockIdx.x); \
        EpiOut E{p.in[0], p.in[1], (const float*)(ws + WS_ADA), p.out + OUT_Y, (float*)(ws + WS_YST)}; \
        pg8::gemm_phase<EpiOut, pg8::StaticOrder>(lds, g, S, E); } while (0)
    if (IN(0)) { phase0(p, lds); if (REP(0)) { xcd_barrier(bar); phase0(p, lds); } } SEAM(0);
    if (IN(1)) { phase1(p); if (REP(1)) { xcd_barrier(bar); phase1(p); } } SEAM(1);
    if (IN(2)) { P2BODY; if (REP(2)) { xcd_barrier(bar); P2BODY; } } SEAM(2);
    if (IN(3)) { phase3(p, lds); if (REP(3)) { xcd_barrier(bar); P2BODY; xcd_barrier(bar); phase3(p, lds); } } SEAM(3);
    if (IN(4)) { phase4(p, lds); if (REP(4)) { xcd_barrier(bar); phase4(p, lds); } } SEAM(4);
    if (IN(5)) { phase5(p); if (REP(5)) { xcd_barrier(bar); phase5(p); } } SEAM(5);
    if (IN(6)) { P6BODY; if (REP(6)) { xcd_barrier(bar); P6BODY; } } SEAM(6);
    if (IN(7)) { P7BODY; if (REP(7)) { xcd_barrier(bar); P7BODY; } } SEAM(7);
    if (IN(8)) { phase8(p); if (REP(8)) { xcd_barrier(bar); P7BODY; xcd_barrier(bar); phase8(p); } }
}

#ifndef N_LAUNCH_SPLIT
#define N_LAUNCH_SPLIT 0
#endif

extern "C" void kernel_launch(void* const* d_in, const int* in_sizes, int n_in, void* d_out, int out_size, void* d_ws, size_t ws_size, hipStream_t stream) {
    static int ready = 0;
    if (!ready) {
        if (n_in != 18 || ws_size < WS_END) { fprintf(stderr, "kernel_launch: unexpected n_in %d or ws_size %zu (need %zu)\n", n_in, ws_size, (size_t)WS_END); }
        if (hipFuncSetAttribute((const void*)fwd_kernel, hipFuncAttributeMaxDynamicSharedMemorySize, LDS_BYTES) != hipSuccess) fprintf(stderr, "kernel_launch: hipFuncSetAttribute failed\n");
        ready = 1;
    }
    Params p; memset(&p, 0, sizeof(p));
    for (int i = 0; i < 18; ++i) p.in[i] = (const float*)d_in[i];
    p.out = (float*)d_out; p.ws = (unsigned char*)d_ws;
    (void)hipMemsetAsync((char*)d_ws + WS_CTL, 0, 1 * MiB, stream);
#if N_LAUNCH_SPLIT
    for (int k = 0; k < NPHASE; ++k) { p.ph_lo = k; p.ph_hi = k + 1; hipLaunchKernelGGL(fwd_kernel, dim3(256), dim3(512), LDS_BYTES, stream, p); }
#else
    p.ph_lo = 0; p.ph_hi = NPHASE; hipLaunchKernelGGL(fwd_kernel, dim3(256), dim3(512), LDS_BYTES, stream, p);
#endif
    hipError_t e = hipGetLastError();
    if (e != hipSuccess) fprintf(stderr, "kernel_launch: launch failed: %s\n", hipGetErrorString(e));
}
```

```cpp
#include <hip/hip_runtime.h>
#include <cstdio>
#include <cstdint>
#include <cstring>

#define LAS __attribute__((address_space(3)))
#define DI __device__ __forceinline__
typedef unsigned short bf16_t;
typedef short bf16x8 __attribute__((ext_vector_type(8)));
typedef float f32x4 __attribute__((ext_vector_type(4)));
typedef unsigned u32x4 __attribute__((ext_vector_type(4)));
typedef unsigned u32x2 __attribute__((ext_vector_type(2)));

constexpr int DM = 1024;
constexpr int NTP = 16384, NTS = 512, NTOK = NTP + NTS, TP = 2048;
constexpr int NB_P = 8, NB_S = 128;
constexpr int PW = 11264;
constexpr int NIN = 11520;
constexpr int C_QG = 0, C_KG = 512, C_VG = 1024, C_ZG = 2048, C_QR = 3072, C_KR = 4096, C_VR = 5120, C_ZR = 7168, C_MG = 9216, C_MR = 10240;
constexpr int UW = 3072;
constexpr int CH = 64;
constexpr int NCHP = NTP / CH;
constexpr float LN_EPS = 1e-5f, HN_EPS = 1e-5f;
constexpr float DN_ALPHA = 1.189207115002721f;

constexpr size_t OUT_Y = 0, OUT_SGP = 17301504, OUT_SRP = 18350080, OUT_SGS = 22544384, OUT_SRS = 39321600;

constexpr size_t MiB = 1024 * 1024;
constexpr size_t WS_CTL = 0;
constexpr size_t WS_ADA = 1 * MiB;
constexpr size_t WS_COS = 3 * MiB;
constexpr size_t WS_SIN = 5 * MiB;
constexpr size_t WS_LR = 7 * MiB;
constexpr size_t WS_LAM = 9 * MiB;
constexpr size_t WS_YST = 10 * MiB;
constexpr size_t WS_STAT = 13 * MiB;
constexpr size_t WS_WIN = 30 * MiB;
constexpr size_t WS_WBR = 54 * MiB;
constexpr size_t WS_WO = 61 * MiB;
constexpr size_t WS_H = 64 * MiB;
constexpr size_t WS_MRG = 98 * MiB;
constexpr size_t WS_O = 132 * MiB;
constexpr size_t WS_U = 232 * MiB;
constexpr size_t WS_P = 332 * MiB;
constexpr size_t WS_END = 700 * MiB;
constexpr int CW_BAR = 4096;

constexpr int LDS_MISC = 147456;
constexpr int LDS_BYTES = 147456 + 1024;

struct Params {
    const float* in[18];
    float* out;
    unsigned char* ws;
    int ph_lo, ph_hi;
};

DI unsigned f2bf(float f) { unsigned u = __builtin_bit_cast(unsigned, f); return (u + 0x7fffu + ((u >> 16) & 1u)) >> 16; }
DI unsigned pk2(float lo, float hi) { return f2bf(lo) | (f2bf(hi) << 16); }
DI float bflo(unsigned w) { return __builtin_bit_cast(float, w << 16); }
DI float bfhi(unsigned w) { return __builtin_bit_cast(float, w & 0xffff0000u); }
DI float bf1(bf16_t b) { return __builtin_bit_cast(float, ((unsigned)b) << 16); }
DI float wave_sum(float v) {
#pragma unroll
    for (int o = 1; o < 64; o <<= 1) v += __shfl_xor(v, o);
    return v;
}
DI float sigmoidf_(float x) { return 1.0f / (1.0f + __expf(-x)); }
DI float siluf_(float x) { return x / (1.0f + __expf(-x)); }
#define LDS_WAIT() asm volatile("s_waitcnt lgkmcnt(0)" ::: "memory")

namespace pg8 {
constexpr int BM = 256, BK = 64, HALF = 128, HTB = HALF * BK * 2, STAGE_BYTES = 8 * HTB, NXCD = 8, WGM = 8;
DI int lds_byte(int r, int c) { const int st = (r >> 4) * 2 + (c >> 5), rr = r & 15, cc = c & 31, ob = rr * 64 + cc * 2; return st * 1024 + (ob ^ (((ob >> 9) & 1) << 5)); }
DI void stage_rc(int b, int& R, int& C) { const int st = b / 1024, sb = b % 1024, swz = sb ^ (((sb >> 9) & 1) << 5); R = (st >> 1) * 16 + swz / 64; C = (st & 1) * 32 + (swz % 64) / 2; }
DI int perm32(int rho) { const int n = rho >> 4, i = rho & 15; return 8 * (i >> 2) + 4 * n + (i & 3); }
struct Unit { int pm, pn; };
struct Gemm { const bf16_t* A; const bf16_t* Bt; int M, N, K; };
struct StaticOrder {
    int nM, nN, nwg, G, c;
    DI void init(int M, int N, int G_, int c_) { nM = M / BM; nN = N / BM; nwg = nM * nN; G = G_; c = c_; }
    DI bool next(int i, Unit& u) const {
        const long L = (long)i * G + c; if (L >= nwg) return false;
        int wgid = (int)L; { const int q = nwg / NXCD, r = nwg % NXCD, xcd = wgid % NXCD, off = wgid / NXCD; wgid = (xcd < r ? xcd * (q + 1) : r * (q + 1) + (xcd - r) * q) + off; }
        const int nig = WGM * nN, gid = wgid / nig, fm = gid * WGM, gsz = (nM - fm) < WGM ? (nM - fm) : WGM;
        u.pm = fm + ((wgid % nig) % gsz); u.pn = (wgid % nig) / gsz; return true;
    }
    DI void a_ready(const Unit&) const {}
    DI void done(const Unit&) const {}
};

template <class Epi, class Sched>
DI void gemm_phase(LAS unsigned char* lds, const Gemm g, const Sched& S, const Epi& E) {
    const int tid = threadIdx.x, wid = __builtin_amdgcn_readfirstlane(tid >> 6), lane = tid & 63, wr = wid >> 2, wc = wid & 3, fr = lane & 15, fq = lane >> 4;
    const int K = g.K, nt = K / BK;
    unsigned voffA[2], voffB[2];
#pragma unroll
    for (int i = 0; i < 2; ++i) { int R, C; stage_rc(tid * 16 + i * 8192, R, C); const int Rb = Epi::PERM ? ((R & ~31) + perm32(R & 31)) : R;
        voffA[i] = (unsigned)(R * K + C) * 2u; voffB[i] = (unsigned)(Rb * K + C) * 2u; }
    const size_t kstep = (size_t)(BK * 2);
    const size_t hstep = (size_t)HALF * K * 2;
    const size_t tstep = 2 * hstep;
    const unsigned ldsw = (unsigned)wid * 1024u;
    const int aoff = lds_byte(wr * 64 + fr, fq * 8), boff = lds_byte(wc * 32 + fr, fq * 8);
#define PG8_SA(b, h) (((b) * 2 + (h)) * HTB)
#define PG8_SB(b, h) ((4 + (b) * 2 + (h)) * HTB)
#define PG8_STAGE(bufoff, gbase, voff) do { _Pragma("unroll") for (int _i = 0; _i < 2; ++_i) \
        __builtin_amdgcn_global_load_lds((const unsigned*)((const char*)(gbase) + (voff)[_i]), (LAS unsigned*)(lds + (bufoff) + ldsw + _i * 8192), 16, 0, 0); } while (0)
#define PG8_LDA(dst, b, h) do { _Pragma("unroll") for (int m = 0; m < 4; ++m) _Pragma("unroll") for (int k = 0; k < 2; ++k) dst[m][k] = *(const LAS bf16x8*)(lds + PG8_SA(b, h) + aoff + m * 2048 + k * 1024); } while (0)
#define PG8_LDB(dst, b, h) do { _Pragma("unroll") for (int n = 0; n < 2; ++n) _Pragma("unroll") for (int k = 0; k < 2; ++k) dst[n][k] = *(const LAS bf16x8*)(lds + PG8_SB(b, h) + boff + n * 2048 + k * 1024); } while (0)
#define PG8_MMA(ai, bj, At, Bt) do { __builtin_amdgcn_s_setprio(1); _Pragma("unroll") for (int m = 0; m < 4; ++m) _Pragma("unroll") for (int n = 0; n < 2; ++n) _Pragma("unroll") for (int k = 0; k < 2; ++k) \
        acc[ai][bj][m][n] = __builtin_amdgcn_mfma_f32_16x16x32_bf16(Bt[n][k], At[m][k], acc[ai][bj][m][n], 0, 0, 0); __builtin_amdgcn_s_setprio(0); } while (0)
#define PG8_WAIT_V(n) asm volatile("s_waitcnt vmcnt(" #n ")" ::: "memory")
#define PG8_WAIT_L(n) asm volatile("s_waitcnt lgkmcnt(" #n ")" ::: "memory")
#define PG8_BAR __builtin_amdgcn_s_barrier()
#define PG8_SCHED __builtin_amdgcn_sched_barrier(0)
    Unit cur, nxt; int ui = 0;
    if (!S.next(0, cur)) return;
    f32x4 acc[2][2][4][2];
#pragma unroll
    for (int a = 0; a < 2; ++a)
#pragma unroll
        for (int b = 0; b < 2; ++b)
#pragma unroll
            for (int m = 0; m < 4; ++m)
#pragma unroll
                for (int n = 0; n < 2; ++n) acc[a][b][m][n] = (f32x4){0.f, 0.f, 0.f, 0.f};
    bf16x8 At[4][2], B0[2][2], B1[2][2];
    const char* cA = (const char*)g.A + (size_t)cur.pm * tstep; const char* cB = (const char*)g.Bt + (size_t)cur.pn * tstep;
    S.a_ready(cur);
    PG8_STAGE(PG8_SB(0, 0), cB, voffB); PG8_STAGE(PG8_SA(0, 0), cA, voffA); PG8_STAGE(PG8_SB(0, 1), cB + hstep, voffB); PG8_STAGE(PG8_SA(0, 1), cA + hstep, voffA);
    if (wr == 1) PG8_BAR;
    PG8_WAIT_V(4); PG8_BAR;
    PG8_STAGE(PG8_SB(1, 0), cB + kstep, voffB); PG8_STAGE(PG8_SA(1, 0), cA + kstep, voffA); PG8_STAGE(PG8_SB(1, 1), cB + hstep + kstep, voffB);
    PG8_WAIT_V(6); PG8_BAR;
    for (;;) {
        const bool has_next = S.next(ui + 1, nxt);
        const char* nA = has_next ? (const char*)g.A + (size_t)nxt.pm * tstep : cA; const char* nB = has_next ? (const char*)g.Bt + (size_t)nxt.pn * tstep : cB;
        for (int t = 0; t < nt; t += 2) {
            const bool last = (t == nt - 2);
            const char* a1 = cA + (size_t)(t + 1) * kstep;
            const char* a2 = last ? nA : cA + (size_t)(t + 2) * kstep; const char* b2 = last ? nB : cB + (size_t)(t + 2) * kstep;
            const char* a3 = a2 + kstep; const char* b3 = b2 + kstep;
            if (last && has_next) S.a_ready(nxt);
            if constexpr (Epi::MID_T > 0) { if (t == Epi::MID_T) E.mid(acc, cur, wr, wc, fr, fq); }
            PG8_LDB(B0, 0, 0); PG8_SCHED; PG8_LDA(At, 0, 0); PG8_STAGE(PG8_SA(1, 1), a1 + hstep, voffA);
            PG8_WAIT_L(8); PG8_BAR; PG8_WAIT_L(0); PG8_MMA(0, 0, At, B0); PG8_BAR; PG8_SCHED;
            PG8_LDB(B1, 0, 1); PG8_STAGE(PG8_SB(0, 0), b2, voffB);
            PG8_BAR; PG8_WAIT_L(0); PG8_MMA(0, 1, At, B1); PG8_BAR;
            PG8_LDA(At, 0, 1); PG8_STAGE(PG8_SA(0, 0), a2, voffA);
            PG8_BAR; PG8_WAIT_L(0); PG8_MMA(1, 0, At, B0); PG8_BAR; PG8_SCHED;
            PG8_STAGE(PG8_SB(0, 1), b2 + hstep, voffB);
            PG8_WAIT_V(6); PG8_BAR; PG8_MMA(1, 1, At, B1); PG8_BAR;
            PG8_LDB(B0, 1, 0); PG8_SCHED; PG8_LDA(At, 1, 0); PG8_STAGE(PG8_SA(0, 1), a2 + hstep, voffA);
            PG8_WAIT_L(8); PG8_BAR; PG8_WAIT_L(0); PG8_MMA(0, 0, At, B0); PG8_BAR; PG8_SCHED;
            PG8_LDB(B1, 1, 1); PG8_STAGE(PG8_SB(1, 0), b3, voffB);
            PG8_BAR; PG8_WAIT_L(0); PG8_MMA(0, 1, At, B1); PG8_BAR;
            PG8_LDA(At, 1, 1); PG8_STAGE(PG8_SA(1, 0), a3, voffA);
            PG8_BAR; PG8_WAIT_L(0); PG8_MMA(1, 0, At, B0); PG8_BAR; PG8_SCHED;
            PG8_STAGE(PG8_SB(1, 1), b3 + hstep, voffB);
            PG8_WAIT_V(6); PG8_BAR; PG8_MMA(1, 1, At, B1); PG8_BAR;
        }
        E(acc, cur, wr, wc, fr, fq); S.done(cur);
        if (!has_next) break;
#pragma unroll
        for (int a = 0; a < 2; ++a)
#pragma unroll
            for (int b = 0; b < 2; ++b)
#pragma unroll
                for (int m = 0; m < 4; ++m)
#pragma unroll
                    for (int n = 0; n < 2; ++n) acc[a][b][m][n] = (f32x4){0.f, 0.f, 0.f, 0.f};
        cur = nxt; cA = nA; cB = nB; ++ui;
    }
    PG8_WAIT_V(0);
    if (wr == 0) PG8_BAR;
    PG8_BAR;
#undef PG8_SA
#undef PG8_SB
#undef PG8_STAGE
#undef PG8_LDA
#undef PG8_LDB
#undef PG8_MMA
#undef PG8_WAIT_V
#undef PG8_WAIT_L
#undef PG8_BAR
#undef PG8_SCHED
}
}

typedef f32x4 AccT[2][2][4][2];

struct EpiIn {
    static constexpr bool PERM = true; static constexpr int MID_T = 0;
    bf16_t* P; float* LR; const float* COS; const float* SIN;
    DI void mid(AccT&, const pg8::Unit&, int, int, int, int) const {}
    DI void operator()(const AccT& acc, const pg8::Unit& u, int wr, int wc, int fr, int fq) const {
        const int pn = u.pn;
        const int row0 = u.pm * 256 + wr * 64 + fr;
        if (pn == 44) {
            if (wc == 0 && fq < 2) {
#pragma unroll
                for (int ai = 0; ai < 2; ++ai)
#pragma unroll
                    for (int m = 0; m < 4; ++m) { const int row = row0 + ai * 128 + m * 16; float* o = LR + (size_t)row * 16 + 8 * fq;
                        *(f32x4*)(o) = acc[ai][0][m][0]; *(f32x4*)(o + 4) = acc[ai][0][m][1]; }
            }
            return;
        }
        const bool rot = (pn >= 12 && pn < 20), isk = (pn >= 16 && pn < 20);
        const int cl = wc * 32 + 8 * fq;
        float l2g = 0.f;
        if (isk) { const int h = pn - 16; l2g = __log2f(1.0f - exp2f(-5.0f - (float)h)); }
#pragma unroll
        for (int ai = 0; ai < 2; ++ai)
#pragma unroll
            for (int m = 0; m < 4; ++m) {
                const int row = row0 + ai * 128 + m * 16;
                f32x4 v00 = acc[ai][0][m][0], v01 = acc[ai][0][m][1], v10 = acc[ai][1][m][0], v11 = acc[ai][1][m][1];
                if (rot) {
                    const int ti = row < NTP ? (row & (TP - 1)) : (TP + (row & 3));
                    const f32x4 c0 = *(const f32x4*)(COS + (size_t)ti * 128 + cl), c1 = *(const f32x4*)(COS + (size_t)ti * 128 + cl + 4);
                    const f32x4 s0 = *(const f32x4*)(SIN + (size_t)ti * 128 + cl), s1 = *(const f32x4*)(SIN + (size_t)ti * 128 + cl + 4);
                    float sc = 1.0f;
                    if (isk) { const int sp = row < NTP ? (row & (CH - 1)) : (row & 3); sc = 0.0625f * exp2f(-(float)(sp + 1) * l2g); }
                    const f32x4 a0 = (v00 * c0 - v10 * s0) * sc, a1 = (v01 * c1 - v11 * s1) * sc;
                    const f32x4 b0 = (v00 * s0 + v10 * c0) * sc, b1 = (v01 * s1 + v11 * c1) * sc;
                    v00 = a0; v01 = a1; v10 = b0; v11 = b1;
                }
                bf16_t* rowp = P + (size_t)row * PW + pn * 256 + cl;
                u32x4 w; w.x = pk2(v00[0], v00[1]); w.y = pk2(v00[2], v00[3]); w.z = pk2(v01[0], v01[1]); w.w = pk2(v01[2], v01[3]);
                *(u32x4*)(rowp) = w;
                w.x = pk2(v10[0], v10[1]); w.y = pk2(v10[2], v10[3]); w.z = pk2(v11[0], v11[1]); w.w = pk2(v11[2], v11[3]);
                *(u32x4*)(rowp + 128) = w;
            }
    }
};

struct EpiBranch {
    static constexpr bool PERM = true; static constexpr int MID_T = 16;
    const bf16_t* P; bf16_t* MRG;
    DI void mid(AccT& acc, const pg8::Unit& u, int wr, int wc, int fr, int fq) const {
        int row0 = u.pm * 256 + wr * 64 + fr, cl = u.pn * 256 + wc * 32 + 8 * fq;
        asm volatile("" : "+v"(row0), "+v"(cl));
#pragma unroll
        for (int ai = 0; ai < 2; ++ai)
#pragma unroll
            for (int m = 0; m < 4; ++m) { const int row = row0 + ai * 128 + m * 16;
#pragma unroll
                for (int bj = 0; bj < 2; ++bj) {
                    const u32x4 g = *(const u32x4*)(P + (size_t)row * PW + C_MG + cl + bj * 128);
                    const u32x4 r = *(const u32x4*)(P + (size_t)row * PW + C_MR + cl + bj * 128);
                    const unsigned gw[4] = {g.x, g.y, g.z, g.w}, rw[4] = {r.x, r.y, r.z, r.w};
#pragma unroll
                    for (int j = 0; j < 4; ++j) {
                        const float mg0 = bflo(gw[j]), mg1 = bfhi(gw[j]); float mr0 = bflo(rw[j]), mr1 = bfhi(rw[j]);
                        mr0 = fmaxf(mr0, -60.f); mr1 = fmaxf(mr1, -60.f);
                        const float q0 = (1.0f + __expf(-mr0)) / (1.0f + __expf(-mg0)), q1 = (1.0f + __expf(-mr1)) / (1.0f + __expf(-mg1));
                        acc[ai][bj][m][j >> 1][(j & 1) * 2] *= q0; acc[ai][bj][m][j >> 1][(j & 1) * 2 + 1] *= q1;
                    }
                    asm volatile("" ::: "memory");
                } }
    }
    DI void operator()(const AccT& acc, const pg8::Unit& u, int wr, int wc, int fr, int fq) const {
        const int row0 = u.pm * 256 + wr * 64 + fr, cl = u.pn * 256 + wc * 32 + 8 * fq;
#pragma unroll
        for (int ai = 0; ai < 2; ++ai)
#pragma unroll
            for (int m = 0; m < 4; ++m) { const int row = row0 + ai * 128 + m * 16;
#pragma unroll
                for (int bj = 0; bj < 2; ++bj) {
                    const u32x4 r = *(const u32x4*)(P + (size_t)row * PW + C_MR + cl + bj * 128);
                    const unsigned rw[4] = {r.x, r.y, r.z, r.w}; unsigned ow[4];
#pragma unroll
                    for (int j = 0; j < 4; ++j) {
                        const float mr0 = fmaxf(bflo(rw[j]), -60.f), mr1 = fmaxf(bfhi(rw[j]), -60.f);
                        const float o0 = acc[ai][bj][m][j >> 1][(j & 1) * 2] * sigmoidf_(mr0), o1 = acc[ai][bj][m][j >> 1][(j & 1) * 2 + 1] * sigmoidf_(mr1);
                        ow[j] = pk2(o0, o1);
                    }
                    u32x4 w; w.x = ow[0]; w.y = ow[1]; w.z = ow[2]; w.w = ow[3];
                    *(u32x4*)(MRG + (size_t)row * DM + cl + bj * 128) = w;
                } }
    }
};

struct EpiOut {
    static constexpr bool PERM = false; static constexpr int MID_T = 0;
    const float* xp; const float* xs; const float* ADA; float* Y; float* YST;
    DI void mid(AccT&, const pg8::Unit&, int, int, int, int) const {}
    DI void operator()(const AccT& acc, const pg8::Unit& u, int wr, int wc, int fr, int fq) const {
        const int row0 = u.pm * 256 + wr * 64 + fr, col0 = u.pn * 256 + wc * 32 + 4 * fq;
#pragma unroll
        for (int ai = 0; ai < 2; ++ai)
#pragma unroll
            for (int m = 0; m < 4; ++m) { const int row = row0 + ai * 128 + m * 16;
                const float* xr = row < NTP ? xp + (size_t)row * DM : xs + (size_t)(row - NTP) * DM;
                const int bidx = row < NTP ? (row >> 11) : (NB_P + ((row - NTP) >> 2));
                const float* gr = ADA + (size_t)bidx * 3072 + 2048;
#pragma unroll
                for (int bj = 0; bj < 2; ++bj)
#pragma unroll
                    for (int n = 0; n < 2; ++n) { const int c = col0 + bj * 128 + n * 16;
                        const f32x4 xv = *(const f32x4*)(xr + c), gv = *(const f32x4*)(gr + c);
                        const f32x4 v = xv * DN_ALPHA + gv * acc[ai][bj][m][n];
                        *(f32x4*)(Y + (size_t)row * DM + c) = v; }
            }
    }
};

#define XB_TMO      128
#define XB_XCNT(j)  (256  + 64 * (j))
#define XB_XSUB(j)  (1280 + 64 * (j))
#define XB_XGEN(j)  (2304 + 64 * (j))
#define XB_TOP      3328
#define XB_TOPGEN   3392
#define XCD_BAR_WORDS 3456
#define XB_SPIN_CAP (1u << 18)
DI unsigned xb_ld(unsigned* p)              { return __hip_atomic_load(p, __ATOMIC_RELAXED, __HIP_MEMORY_SCOPE_AGENT); }
DI unsigned xb_add(unsigned* p, unsigned v) { return __hip_atomic_fetch_add(p, v, __ATOMIC_RELAXED, __HIP_MEMORY_SCOPE_AGENT); }
DI unsigned xb_xcc_id() { return (unsigned)__builtin_amdgcn_s_getreg((3 << 11) | 20) & 0xFu; }
#define XB_SPIN(cond, bar) do { unsigned _sp = 0; while (cond) { __builtin_amdgcn_s_sleep(1); \
    if ((++_sp & 255u) == 0u) { if (xb_ld(&(bar)[XB_TMO])) break; if (_sp > XB_SPIN_CAP) { atomicAdd(&(bar)[XB_TMO], 1u); break; } } } } while (0)
struct XcdBarrier { unsigned* bar; unsigned x; volatile LAS unsigned* st; };
DI XcdBarrier xcd_barrier_post(unsigned* bar, volatile LAS unsigned* st) {
    XcdBarrier b; b.bar = bar; b.x = xb_xcc_id(); b.st = st;
    if (threadIdx.x == 0) (void)xb_add(&bar[XB_XCNT(b.x)], 1u);
    return b;
}
DI void xcd_barrier_complete(unsigned* bar, unsigned x, unsigned& nloc, unsigned& nx) {
    const unsigned G = gridDim.x * gridDim.y * gridDim.z;
    unsigned sum, cnt, mine, sp = 0u;
    for (;;) {
        sum = 0u; cnt = 0u; mine = 0u;
#pragma unroll
        for (unsigned j = 0; j < 16; ++j) { const unsigned c = xb_ld(&bar[XB_XCNT(j)]); sum += c; cnt += (c > 0u) ? 1u : 0u; mine = (j == x) ? c : mine; }
        if (sum == G) break;
        __builtin_amdgcn_s_sleep(1);
        if ((++sp & 255u) == 0u) { if (xb_ld(&bar[XB_TMO])) break; if (sp > XB_SPIN_CAP) { atomicAdd(&bar[XB_TMO], 1u); break; } }
    }
    nloc = mine > 0u ? mine : 1u; nx = cnt > 0u ? cnt : 1u;
}
DI void xcd_barrier(const XcdBarrier& b) {
    asm volatile("s_waitcnt vmcnt(0)" ::: "memory");
    __syncthreads();
    if (threadIdx.x == 0) {
        unsigned* bar = b.bar;
        __builtin_amdgcn_s_waitcnt(0);
        unsigned nloc = b.st[0], nx = b.st[1];
        if (nloc == 0u) { xcd_barrier_complete(bar, b.x, nloc, nx); b.st[0] = nloc; b.st[1] = nx; }
        const unsigned old = xb_add(&bar[XB_XSUB(b.x)], 1u);
        const unsigned gen = old / nloc;
        if (old + 1u == (gen + 1u) * nloc) {
            __builtin_amdgcn_fence(__ATOMIC_RELEASE, "agent");
            asm volatile("s_waitcnt vmcnt(0)" ::: "memory");
            const unsigned og = xb_add(&bar[XB_TOP], 1u);
            const unsigned tg = og / nx;
            if (og + 1u == (tg + 1u) * nx) xb_add(&bar[XB_TOPGEN], 1u);
            else XB_SPIN(xb_ld(&bar[XB_TOPGEN]) == tg, bar);
            __builtin_amdgcn_fence(__ATOMIC_ACQUIRE, "agent");
            xb_add(&bar[XB_XGEN(b.x)], 1u);
            asm volatile("s_waitcnt vmcnt(0)" ::: "memory");
        } else {
            XB_SPIN(xb_ld(&bar[XB_XGEN(b.x)]) == gen, bar);
            __builtin_amdgcn_fence(__ATOMIC_ACQUIRE, "agent");
            asm volatile("s_waitcnt vmcnt(0)" ::: "memory");
        }
    }
    __syncthreads();
}

template <int MODE>
DI void transpose_item(const float* W, int N, bf16_t* WT, int ldk, int koff, LAS float* scr, int kb, int nb, int lane) {
    const int k0 = 64 * kb, n0 = 32 * nb;
    const int n = n0 + (lane & 31);
    int src = n;
    if (MODE == 1) src = n < 3072 ? n : (n < 11264 ? n + 16 : (n < 11280 ? 3072 + (n - 11264) : -1));
    float tv[32];
#pragma unroll
    for (int i = 0; i < 32; ++i) { const int kk = 2 * i + (lane >> 5); tv[i] = src >= 0 ? W[(size_t)(k0 + kk) * N + src] : 0.f; }
#pragma unroll
    for (int i = 0; i < 32; ++i) { const int kk = 2 * i + (lane >> 5); scr[kk * 33 + (lane & 31)] = tv[i]; }
    LDS_WAIT(); asm volatile("" ::: "memory");
    const int c = lane & 7;
#pragma unroll
    for (int j = 0; j < 4; ++j) { const int nn = (lane >> 3) + 8 * j; const LAS float* s = scr + (8 * c) * 33 + nn;
        u32x4 o; o.x = pk2(s[0 * 33], s[1 * 33]); o.y = pk2(s[2 * 33], s[3 * 33]); o.z = pk2(s[4 * 33], s[5 * 33]); o.w = pk2(s[6 * 33], s[7 * 33]);
        *(u32x4*)(WT + (size_t)(n0 + nn) * ldk + koff + k0 + 8 * c) = o; }
    LDS_WAIT(); asm volatile("" ::: "memory");
}

DI void phase0(const Params& p, LAS unsigned char* lds) {
    const int tid = threadIdx.x, lane = tid & 63, wave = __builtin_amdgcn_readfirstlane(tid >> 6);
    const int G = gridDim.x, bx = blockIdx.x;
    unsigned char* ws = p.ws;
    {
        LAS float* scr = (LAS float*)(lds + wave * 16384);
        const int gw = bx * 8 + wave, NGW = G * 8;
        constexpr int I_IN = 16 * (NIN / 32), I_BG = 16 * 32, I_BR = 32 * 32, I_O = 16 * 32;
        constexpr int NIT = I_IN + I_BG + I_BR + I_O;
        for (int it = gw; it < NIT; it += NGW) {
            int r = it;
            if (r < I_IN) { transpose_item<1>(p.in[8], 11280, (bf16_t*)(ws + WS_WIN), 1024, 0, scr, r / (NIN / 32), r % (NIN / 32), lane); continue; } r -= I_IN;
            if (r < I_BG) { transpose_item<0>(p.in[13], 1024, (bf16_t*)(ws + WS_WBR), 3072, 0, scr, r / 32, r % 32, lane); continue; } r -= I_BG;
            if (r < I_BR) { transpose_item<0>(p.in[14], 1024, (bf16_t*)(ws + WS_WBR), 3072, 1024, scr, r / 32, r % 32, lane); continue; } r -= I_BR;
            transpose_item<0>(p.in[15], 1024, (bf16_t*)(ws + WS_WO), 1024, 0, scr, r / 32, r % 32, lane);
        }
    }
    {
        float* COS = (float*)(ws + WS_COS); float* SIN = (float*)(ws + WS_SIN);
        for (int i = bx * 512 + tid; i < 2052 * 128; i += G * 512) {
            const int ti = i >> 7, j = i & 127;
            const double pos = ti < TP ? (double)ti : (double)(16384 + (ti - TP));
            const double inv = exp(-(double)j * (9.210340371976184 / 128.0));
            const double ang = pos * inv;
            const double red = ang - 6.283185307179586476925 * rint(ang * 0.15915494309189533577);
            float sn, cs_; sincosf((float)red, &sn, &cs_);
            COS[i] = cs_; SIN[i] = sn;
        }
    }
    __syncthreads();
    {
        const float* wada = p.in[6]; const float* bada = p.in[7];
        float* ADA = (float*)(ws + WS_ADA);
        LAS float* cs = (LAS float*)lds;
        LAS float* red = (LAS float*)(lds + 65536);
        for (int task = bx; task < 9 * 48; task += G) {
            const int rg = task / 48, cb = task % 48, r0 = rg * 16, j0 = cb * 64;
            __syncthreads();
            for (int i = tid; i < 16 * 256; i += 512) { const int r = r0 + (i >> 8), k = (i & 255) * 4;
                f32x4 v = (f32x4){0.f, 0.f, 0.f, 0.f}; if (r < 136) v = r < NB_P ? *(const f32x4*)(p.in[4] + (size_t)r * 1024 + k) : *(const f32x4*)(p.in[5] + (size_t)(r - NB_P) * 1024 + k);
                *(LAS f32x4*)(cs + (i >> 8) * 1024 + k) = v; }
            __syncthreads();
            float a[16];
#pragma unroll
            for (int r = 0; r < 16; ++r) a[r] = 0.f;
            const int kbeg = wave * 128;
            for (int kb2 = kbeg; kb2 < kbeg + 128; kb2 += 32) {
                float wv[32];
#pragma unroll
                for (int q = 0; q < 32; ++q) wv[q] = wada[(size_t)(kb2 + q) * 3072 + j0 + lane];
#pragma unroll
                for (int q = 0; q < 32; q += 4) {
#pragma unroll
                    for (int r = 0; r < 16; ++r) { const f32x4 cv = *(const LAS f32x4*)(cs + r * 1024 + kb2 + q);
                        a[r] += cv[0] * wv[q] + cv[1] * wv[q + 1] + cv[2] * wv[q + 2] + cv[3] * wv[q + 3]; }
                    asm volatile("" ::: "memory");
                }
            }
#pragma unroll
            for (int r = 0; r < 16; ++r) red[(wave * 16 + r) * 64 + lane] = a[r];
            __syncthreads();
            for (int i = tid; i < 16 * 64; i += 512) { const int r = i >> 6, j = i & 63; float s = 0.f;
#pragma unroll
                for (int w = 0; w < 8; ++w) s += red[(w * 16 + r) * 64 + j];
                if (r0 + r < 136) ADA[(size_t)(r0 + r) * 3072 + j0 + j] = s + bada[j0 + j]; }
        }
        __syncthreads();
    }
}

DI void phase1(const Params& p) {
    const int tid = threadIdx.x, lane = tid & 63, wave = tid >> 6;
    const int gw = blockIdx.x * 8 + wave, NGW = gridDim.x * 8;
    const float* ADA = (const float*)(p.ws + WS_ADA); bf16_t* H = (bf16_t*)(p.ws + WS_H);
    for (int row = gw; row < NTOK; row += NGW) {
        const float* xr = row < NTP ? p.in[0] + (size_t)row * DM : p.in[1] + (size_t)(row - NTP) * DM;
        const int bidx = row < NTP ? (row >> 11) : (NB_P + ((row - NTP) >> 2));
        const float* ar = ADA + (size_t)bidx * 3072;
#pragma unroll
        for (int j = 0; j < 4; ++j) { const int c = 4 * lane + 256 * j;
            const f32x4 xv = *(const f32x4*)(xr + c), sh = *(const f32x4*)(ar + c), sc = *(const f32x4*)(ar + 1024 + c);
            const f32x4 hv = xv * (sc + 1.0f) + sh;
            u32x2 w; w.x = pk2(hv[0], hv[1]); w.y = pk2(hv[2], hv[3]);
            *(u32x2*)(H + (size_t)row * DM + c) = w; }
    }
}

DI void phase3(const Params& p, LAS unsigned char* lds) {
    const int tid = threadIdx.x;
    bf16_t* P = (bf16_t*)(p.ws + WS_P); const float* LR = (const float*)(p.ws + WS_LR); float* LAM = (float*)(p.ws + WS_LAM);
    const float* wl = p.in[9]; const float* bl = p.in[10];
    LAS float* lrs = (LAS float*)lds;
    LAS float* ebuf = (LAS float*)(lds + 4096);
    float w[16];
#pragma unroll
    for (int j = 0; j < 16; ++j) w[j] = wl[j * 512 + tid];
    const float bias = bl[tid];
    for (int item = blockIdx.x; item < NCHP + NB_S; item += gridDim.x) {
        const int tok0 = item < NCHP ? item * CH : NTP + (item - NCHP) * 4;
        const int nt = item < NCHP ? CH : 4;
        __syncthreads();
        for (int i = tid; i < nt * 16; i += 512) lrs[i] = LR[(size_t)tok0 * 16 + i];
        __syncthreads();
        float bc = 0.f;
        for (int t = 0; t < nt; ++t) {
            float x = bias;
#pragma unroll
            for (int j = 0; j < 16; j += 4) { const f32x4 l4 = *(const LAS f32x4*)(lrs + t * 16 + j); x += l4[0] * w[j] + l4[1] * w[j + 1] + l4[2] * w[j + 2] + l4[3] * w[j + 3]; }
            const float ls = fminf(x, 0.f) - log1pf(expf(-fabsf(x)));
            bc += ls * 0.0625f;
            ebuf[t * 512 + tid] = expf(bc);
        }
        LAM[(size_t)item * 512 + tid] = expf(bc);
        __syncthreads();
        for (int it = tid; it < nt * 64; it += 512) {
            const int t = it >> 6, c8 = (it & 63) * 8;
            bf16_t* pr = P + (size_t)(tok0 + t) * PW;
            const u32x4 qv = *(const u32x4*)(pr + C_QG + c8), kv = *(const u32x4*)(pr + C_KG + c8);
            const f32x4 e0 = *(const LAS f32x4*)(ebuf + t * 512 + c8), e1 = *(const LAS f32x4*)(ebuf + t * 512 + c8 + 4);
            const float ev[8] = {e0[0], e0[1], e0[2], e0[3], e1[0], e1[1], e1[2], e1[3]};
            const unsigned qw[4] = {qv.x, qv.y, qv.z, qv.w}, kw[4] = {kv.x, kv.y, kv.z, kv.w}; unsigned qo[4], ko[4];
#pragma unroll
            for (int j = 0; j < 4; ++j) {
                const float ea = ev[2 * j], eb = ev[2 * j + 1];
                qo[j] = pk2(bflo(qw[j]) * ea * 0.08838834764831845f, bfhi(qw[j]) * eb * 0.08838834764831845f);
                ko[j] = pk2(bflo(kw[j]) / ea, bfhi(kw[j]) / eb);
            }
            u32x4 o; o.x = qo[0]; o.y = qo[1]; o.z = qo[2]; o.w = qo[3]; *(u32x4*)(pr + C_QG + c8) = o;
            o.x = ko[0]; o.y = ko[1]; o.z = ko[2]; o.w = ko[3]; *(u32x4*)(pr + C_KG + c8) = o;
        }
    }
}

template <int RS> DI int imgaddr(int row, int col) {
    const int swz = RS == 128 ? ((row >> 1) & 7) : (row & 15);
    return row * RS + ((((col >> 3) ^ swz)) << 4) + ((col & 7) << 1);
}
template <int RS> DI bf16x8 frag(const LAS unsigned char* base, int rb, int ks, int lane) {
    return *(const LAS bf16x8*)(base + imgaddr<RS>(16 * rb + (lane & 15), 32 * ks + 8 * (lane >> 4)));
}
#define MFMA16(a, b, c) __builtin_amdgcn_mfma_f32_16x16x32_bf16((a), (b), (c), 0, 0, 0)

template <int DK, bool RET>
DI void prompt_task(const Params& p, LAS unsigned char* lds, int b, int h, int slice) {
    constexpr int RSQ = DK * 2;
    constexpr int OFF_Q = 0, OFF_K = 64 * RSQ, OFF_KT = 2 * 64 * RSQ, OFF_VT = OFF_KT + DK * 128, OFF_P = OFF_VT + 8192, OFF_S = OFF_P + 8192;
    constexpr int CPR = DK / 8;
    constexpr int NQ = 64 * CPR / 512;
    constexpr int NDB = DK / 128;
    constexpr int DV = RET ? 512 : 256;
    const int tid = threadIdx.x, lane = tid & 63, w = __builtin_amdgcn_readfirstlane(tid >> 6), r = lane & 15, g = lane >> 4;
    const bf16_t* P = (const bf16_t*)(p.ws + WS_P);
    bf16_t* O = (bf16_t*)(p.ws + WS_O); float* STAT = (float*)(p.ws + WS_STAT); const float* LAM = (const float*)(p.ws + WS_LAM);
    const int colQ = (RET ? C_QR : C_QG) + h * DK, colK = (RET ? C_KR : C_KG) + h * DK, colV = (RET ? C_VR : C_VG) + h * DV + slice * 64;
    const int ocol = (RET ? 1024 : 0) + h * DV + slice * 64;
    const int headidx = RET ? 4 + h : h;
    const float l2g = RET ? __log2f(1.0f - exp2f(-5.0f - (float)h)) : 0.f;
    const float gC = RET ? exp2f((float)CH * l2g) : 1.f;

    f32x4 accS[NDB][4];
#pragma unroll
    for (int j = 0; j < NDB; ++j)
#pragma unroll
        for (int v = 0; v < 4; ++v) accS[j][v] = (f32x4){0.f, 0.f, 0.f, 0.f};
    __syncthreads();
    for (int i = tid; i < 64 * RSQ / 16; i += 512) *(LAS u32x4*)(lds + OFF_S + i * 16) = (u32x4){0u, 0u, 0u, 0u};

    constexpr int NKI = 32 * CPR / 512;
    u32x4 rq[NQ], rk[NKI][2], rv[2];
    unsigned pfv = 0u, pfacc = 0u;
    const int vsp = tid & 31, vch = tid >> 5;
    rv[0] = (u32x4){0u, 0u, 0u, 0u}; rv[1] = rv[0];
    {
        const size_t tok0 = (size_t)b * TP;
#pragma unroll
        for (int i = 0; i < NQ; ++i) { const int id = tid + 512 * i, row = id / CPR, ch = id % CPR; rq[i] = *(const u32x4*)(P + (tok0 + row) * PW + colQ + ch * 8); }
#pragma unroll
        for (int j = 0; j < NKI; ++j) { const int id = tid + 512 * j, sp = id & 31, ch = id >> 5;
            rk[j][0] = *(const u32x4*)(P + (tok0 + 2 * sp) * PW + colK + ch * 8); rk[j][1] = *(const u32x4*)(P + (tok0 + 2 * sp + 1) * PW + colK + ch * 8); }
        if (tid < 256) { rv[0] = *(const u32x4*)(P + (tok0 + 2 * vsp) * PW + colV + vch * 8); rv[1] = *(const u32x4*)(P + (tok0 + 2 * vsp + 1) * PW + colV + vch * 8); }
    }
    for (int c = 0; c < TP / CH; ++c) {
        const size_t tok0 = (size_t)b * TP + (size_t)c * CH;
#pragma unroll
        for (int i = 0; i < NQ; ++i) { const int id = tid + 512 * i, row = id / CPR, ch = id % CPR; *(LAS u32x4*)(lds + OFF_Q + imgaddr<RSQ>(row, ch * 8)) = rq[i]; }
#pragma unroll
        for (int j = 0; j < NKI; ++j) { const int id = tid + 512 * j, sp = id & 31, ch = id >> 5;
            *(LAS u32x4*)(lds + OFF_K + imgaddr<RSQ>(2 * sp, ch * 8)) = rk[j][0];
            *(LAS u32x4*)(lds + OFF_K + imgaddr<RSQ>(2 * sp + 1, ch * 8)) = rk[j][1];
            const unsigned k0[4] = {rk[j][0].x, rk[j][0].y, rk[j][0].z, rk[j][0].w}, k1[4] = {rk[j][1].x, rk[j][1].y, rk[j][1].z, rk[j][1].w};
#pragma unroll
            for (int e = 0; e < 8; ++e) { const unsigned lo = (k0[e >> 1] >> ((e & 1) * 16)) & 0xffffu, hi = (k1[e >> 1] >> ((e & 1) * 16)) & 0xffffu;
                *(LAS unsigned*)(lds + OFF_KT + imgaddr<128>(ch * 8 + e, 2 * sp)) = lo | (hi << 16); }
        }
        if (tid < 256) { const unsigned v0[4] = {rv[0].x, rv[0].y, rv[0].z, rv[0].w}, v1[4] = {rv[1].x, rv[1].y, rv[1].z, rv[1].w};
#pragma unroll
            for (int e = 0; e < 8; ++e) { const unsigned lo = (v0[e >> 1] >> ((e & 1) * 16)) & 0xffffu, hi = (v1[e >> 1] >> ((e & 1) * 16)) & 0xffffu;
                *(LAS unsigned*)(lds + OFF_VT + imgaddr<128>(vch * 8 + e, 2 * vsp)) = lo | (hi << 16); } }
        __syncthreads();
        pfacc ^= pfv;
        if (c + 2 < TP / CH) {
            const size_t t2 = tok0 + 2 * CH;
            constexpr int NSL = RET ? 8 : 4, LPR = DK / 64  , NLN = 2 * 64 * LPR / NSL  ;
            if (tid < NLN) { const int line = tid * NSL + slice, which = line / (64 * LPR), row = (line % (64 * LPR)) / LPR, seg = line % LPR;
                pfv = *(const unsigned*)(P + (t2 + row) * PW + (which ? colK : colQ) + seg * 64); }
            else if (tid >= 256 && tid < 320) pfv = *(const unsigned*)(P + (t2 + (tid - 256)) * PW + colV);
        }
        if (c + 1 < TP / CH) {
            const size_t tn = tok0 + CH;
#pragma unroll
            for (int i = 0; i < NQ; ++i) { const int id = tid + 512 * i, row = id / CPR, ch = id % CPR; rq[i] = *(const u32x4*)(P + (tn + row) * PW + colQ + ch * 8); }
#pragma unroll
            for (int j = 0; j < NKI; ++j) { const int id = tid + 512 * j, sp = id & 31, ch = id >> 5;
                rk[j][0] = *(const u32x4*)(P + (tn + 2 * sp) * PW + colK + ch * 8); rk[j][1] = *(const u32x4*)(P + (tn + 2 * sp + 1) * PW + colK + ch * 8); }
            if (tid < 256) { rv[0] = *(const u32x4*)(P + (tn + 2 * vsp) * PW + colV + vch * 8); rv[1] = *(const u32x4*)(P + (tn + 2 * vsp + 1) * PW + colV + vch * 8); }
        }
        {
            const int tb = w & 3, sh = w >> 2;
            f32x4 a1[2]; a1[0] = (f32x4){0.f, 0.f, 0.f, 0.f}; a1[1] = a1[0];
            if (!(sh == 1 && tb < 2)) {
#pragma unroll 4
                for (int ks = 0; ks < DK / 32; ++ks) {
                    const bf16x8 qB = frag<RSQ>(lds + OFF_Q, tb, ks, lane);
                    const bf16x8 k0 = frag<RSQ>(lds + OFF_K, 2 * sh, ks, lane), k1 = frag<RSQ>(lds + OFF_K, 2 * sh + 1, ks, lane);
                    a1[0] = MFMA16(k0, qB, a1[0]); a1[1] = MFMA16(k1, qB, a1[1]);
                }
            }
#pragma unroll
            for (int i = 0; i < 2; ++i) { const int t = 16 * tb + r, s0 = 16 * (2 * sh + i) + 4 * g;
                const float e0 = (s0 + 0 <= t) ? a1[i][0] : 0.f, e1 = (s0 + 1 <= t) ? a1[i][1] : 0.f, e2 = (s0 + 2 <= t) ? a1[i][2] : 0.f, e3 = (s0 + 3 <= t) ? a1[i][3] : 0.f;
                u32x2 pw; pw.x = pk2(e0, e1); pw.y = pk2(e2, e3);
                *(LAS u32x2*)(lds + OFF_P + imgaddr<128>(t, s0)) = pw; }
        }
        __syncthreads();
        {
            const int tb = w & 3, vb0 = 2 * (w >> 2);
            f32x4 a2[2]; a2[0] = (f32x4){0.f, 0.f, 0.f, 0.f}; a2[1] = a2[0];
#pragma unroll
            for (int ks = 0; ks < 2; ++ks) {
                const bf16x8 pB = frag<128>(lds + OFF_P, tb, ks, lane);
#pragma unroll
                for (int i = 0; i < 2; ++i) { const bf16x8 vA = frag<128>(lds + OFF_VT, vb0 + i, ks, lane); a2[i] = MFMA16(vA, pB, a2[i]); }
            }
#pragma unroll 4
            for (int ks = 0; ks < DK / 32; ++ks) {
                const bf16x8 qB = frag<RSQ>(lds + OFF_Q, tb, ks, lane);
#pragma unroll
                for (int i = 0; i < 2; ++i) { const bf16x8 sA = frag<RSQ>(lds + OFF_S, vb0 + i, ks, lane); a2[i] = MFMA16(sA, qB, a2[i]); }
            }
            const int tl = 16 * tb + r; const size_t token = tok0 + tl;
            const float sc = RET ? exp2f((float)(tl + 1) * l2g) : 1.f;
            float s1 = 0.f, s2 = 0.f;
#pragma unroll
            for (int i = 0; i < 2; ++i) { a2[i] = a2[i] * sc;
                s1 += (a2[i][0] + a2[i][1]) + (a2[i][2] + a2[i][3]);
                s2 += (a2[i][0] * a2[i][0] + a2[i][1] * a2[i][1]) + (a2[i][2] * a2[i][2] + a2[i][3] * a2[i][3]);
                u32x2 ow; ow.x = pk2(a2[i][0], a2[i][1]); ow.y = pk2(a2[i][2], a2[i][3]);
                *(u32x2*)(O + token * UW + ocol + 16 * (vb0 + i) + 4 * g) = ow; }
            s1 += __shfl_xor(s1, 16); s1 += __shfl_xor(s1, 32); s2 += __shfl_xor(s2, 16); s2 += __shfl_xor(s2, 32);
            if (g == 0) { float* so = STAT + ((token * 8 + headidx) * 16 + slice * 2 + (w >> 2)) * 2; so[0] = s1; so[1] = s2; }
        }
        {
#pragma unroll
            for (int ks = 0; ks < 2; ++ks) {
                bf16x8 vB[4];
#pragma unroll
                for (int v = 0; v < 4; ++v) vB[v] = frag<128>(lds + OFF_VT, v, ks, lane);
#pragma unroll
                for (int j = 0; j < NDB; ++j) { const bf16x8 kA = frag<128>(lds + OFF_KT, w * NDB + j, ks, lane);
#pragma unroll
                    for (int v = 0; v < 4; ++v) accS[j][v] = MFMA16(kA, vB[v], accS[j][v]); }
            }
#pragma unroll
            for (int j = 0; j < NDB; ++j) {
                f32x4 lam;
                if (RET) lam = (f32x4){gC, gC, gC, gC};
                else lam = *(const f32x4*)(LAM + (size_t)(b * (TP / CH) + c) * 512 + h * 128 + 16 * (w * NDB + j) + 4 * g);
#pragma unroll
                for (int v = 0; v < 4; ++v) accS[j][v] = accS[j][v] * lam;
            }
        }
        __syncthreads();
#pragma unroll
        for (int j = 0; j < NDB; ++j)
#pragma unroll
            for (int v = 0; v < 4; ++v) { u32x2 sw; sw.x = pk2(accS[j][v][0], accS[j][v][1]); sw.y = pk2(accS[j][v][2], accS[j][v][3]);
                *(LAS u32x2*)(lds + OFF_S + imgaddr<RSQ>(16 * v + r, 16 * (w * NDB + j) + 4 * g)) = sw; }
    }
    pfacc ^= pfv;
    if (pfacc == 0x9e3779b9u) ((unsigned*)(p.ws + WS_CTL))[8] = pfacc;
    float* So = p.out + (RET ? OUT_SRP : OUT_SGP) + ((size_t)(b * 4 + h) * DK) * DV + slice * 64;
#pragma unroll
    for (int j = 0; j < NDB; ++j)
#pragma unroll
        for (int v = 0; v < 4; ++v)
#pragma unroll
            for (int e = 0; e < 4; ++e) So[(size_t)(16 * (w * NDB + j) + 4 * g + e) * DV + 16 * v + r] = accS[j][v][e];
}

template <int DK, bool RET>
DI void sample_task(const Params& p, LAS unsigned char* lds, int b, int h) {
    constexpr int DV = RET ? 512 : 256;
    constexpr int NCG = DV / 4;
    constexpr int NRG = 512 / NCG;
    constexpr int RPT = DK / NRG;
    const int tid = threadIdx.x, lane = tid & 63, w = tid >> 6;
    const bf16_t* P = (const bf16_t*)(p.ws + WS_P); bf16_t* U = (bf16_t*)(p.ws + WS_U); const float* LAM = (const float*)(p.ws + WS_LAM);
    const int colQ = (RET ? C_QR : C_QG) + h * DK, colK = (RET ? C_KR : C_KG) + h * DK, colV = (RET ? C_VR : C_VG) + h * DV, colZ = (RET ? C_ZR : C_ZG) + h * DV;
    const int ucol = (RET ? 1024 : 0) + h * DV;
    const size_t tok0 = (size_t)NTP + (size_t)b * 4;
    const float l2g = RET ? __log2f(1.0f - exp2f(-5.0f - (float)h)) : 0.f;
    LAS float* qs = (LAS float*)lds;
    LAS float* ks = qs + 4 * DK;
    LAS float* lam = ks + 4 * DK;
    LAS float* am = lam + DK;
    LAS float* st = am + 16;
    LAS float* red = (LAS float*)(lds + 16384);
    __syncthreads();
    for (int i = tid; i < 4 * DK; i += 512) { const int t = i / DK, d = i % DK;
        qs[i] = bf1(P[(tok0 + t) * PW + colQ + d]); ks[i] = bf1(P[(tok0 + t) * PW + colK + d]); }
    for (int i = tid; i < DK; i += 512) lam[i] = RET ? exp2f(4.0f * l2g) : LAM[(size_t)(NCHP + b) * 512 + h * 128 + i];
    __syncthreads();
    for (int pr = w; pr < 16; pr += 8) { const int t = pr >> 2, s = pr & 3; float a = 0.f;
        for (int d = lane; d < DK; d += 64) a += qs[t * DK + d] * ks[s * DK + d];
        a = wave_sum(a); if (lane == 0) am[pr] = (s <= t) ? a : 0.f; }
    const int cg = tid % NCG, rg = tid / NCG;
    f32x4 vv[4], oo[4];
#pragma unroll
    for (int t = 0; t < 4; ++t) { const u32x2 x = *(const u32x2*)(P + (tok0 + t) * PW + colV + 4 * cg);
        vv[t] = (f32x4){bflo(x.x), bfhi(x.x), bflo(x.y), bfhi(x.y)}; oo[t] = (f32x4){0.f, 0.f, 0.f, 0.f}; }
    const float* S0 = p.in[RET ? 3 : 2] + ((size_t)(b * 4 + h) * DK) * DV + 4 * cg;
    float* S1 = p.out + (RET ? OUT_SRS : OUT_SGS) + ((size_t)(b * 4 + h) * DK) * DV + 4 * cg;
    constexpr int SB = 16;
    for (int i0 = 0; i0 < RPT; i0 += SB) {
        f32x4 sv[SB];
#pragma unroll
        for (int q = 0; q < SB; ++q) sv[q] = __builtin_nontemporal_load((const f32x4*)(S0 + (size_t)(rg + NRG * (i0 + q)) * DV));
#pragma unroll
        for (int q = 0; q < SB; ++q) {
            const int d = rg + NRG * (i0 + q);
            f32x4 n = sv[q];
#pragma unroll
            for (int t = 0; t < 4; ++t) { n += vv[t] * ks[t * DK + d]; oo[t] += sv[q] * qs[t * DK + d]; }
            __builtin_nontemporal_store(n * lam[d], (f32x4*)(S1 + (size_t)d * DV));
        }
    }
#pragma unroll
    for (int t = 0; t < 4; ++t) *(LAS f32x4*)(red + ((rg * 4 + t) * DV + 4 * cg)) = oo[t];
    __syncthreads();
    const int ft = tid / NCG, fcg = tid % NCG; const bool fin = tid < 4 * NCG;
    f32x4 o = (f32x4){0.f, 0.f, 0.f, 0.f};
    if (fin) {
#pragma unroll
        for (int q = 0; q < NRG; ++q) o += *(const LAS f32x4*)(red + ((q * 4 + ft) * DV + 4 * fcg));
#pragma unroll
        for (int s = 0; s < 4; ++s) o += vv[s] * am[ft * 4 + s];
        if (RET) o = o * exp2f((float)(ft + 1) * l2g);
        float s1 = (o[0] + o[1]) + (o[2] + o[3]), s2 = (o[0] * o[0] + o[1] * o[1]) + (o[2] * o[2] + o[3] * o[3]);
        s1 = wave_sum(s1); s2 = wave_sum(s2);
        if (lane == 0) { st[w * 2] = s1; st[w * 2 + 1] = s2; }
    }
    __syncthreads();
    if (fin) {
        constexpr int WPT = NCG / 64;
        float s1 = 0.f, s2 = 0.f;
#pragma unroll
        for (int q = 0; q < WPT; ++q) { s1 += st[(ft * WPT + q) * 2]; s2 += st[(ft * WPT + q) * 2 + 1]; }
        float mu = 0.f, rstd;
        if (RET) { mu = s1 * (1.0f / DV); rstd = rsqrtf(fmaxf(s2 * (1.0f / DV) - mu * mu, 0.f) + HN_EPS); }
        else rstd = rsqrtf(s2 * (1.0f / DV) + HN_EPS);
        const float* gn = p.in[RET ? 12 : 11] + h * DV + 4 * fcg;
        const f32x4 gv = *(const f32x4*)gn;
        const u32x2 zx = *(const u32x2*)(P + (tok0 + ft) * PW + colZ + 4 * fcg);
        const f32x4 z = (f32x4){bflo(zx.x), bfhi(zx.x), bflo(zx.y), bfhi(zx.y)};
        f32x4 u;
#pragma unroll
        for (int e = 0; e < 4; ++e) u[e] = (o[e] - mu) * rstd * gv[e] * siluf_(z[e]);
        u32x2 uw; uw.x = pk2(u[0], u[1]); uw.y = pk2(u[2], u[3]);
        *(u32x2*)(U + (tok0 + ft) * UW + ucol + 4 * fcg) = uw;
    }
}

DI void phase4(const Params& p, LAS unsigned char* lds) {
    const int bx = blockIdx.x;
    volatile LAS unsigned* MISC = (volatile LAS unsigned*)(lds + LDS_MISC);
#ifndef REP4
#define REP4 0
#endif
    if (gridDim.x == 256) {
        const int xcd = bx & 7, i = bx >> 3;
        for (int rep = 0; rep < 1 + (REP4 & 1); ++rep)
        { const int grp = xcd * 4 + (i >> 3); prompt_task<256, true>(p, lds, grp >> 2, grp & 3, i & 7); }
        for (int rep = 0; rep < 1 + ((REP4 >> 1) & 1); ++rep)
        if (i < 16) { const int grp = xcd * 4 + (i >> 2); prompt_task<128, false>(p, lds, grp >> 2, grp & 3, i & 3); }
    } else {
        for (int t = bx; t < 256; t += gridDim.x) prompt_task<256, true>(p, lds, t >> 5, (t >> 3) & 3, t & 7);
        for (int t = bx; t < 128; t += gridDim.x) prompt_task<128, false>(p, lds, t >> 4, (t >> 2) & 3, t & 3);
    }
    unsigned* qctr = (unsigned*)(p.ws + WS_CTL) + 64;
    for (;;) {
        __syncthreads();
        if (threadIdx.x == 0) MISC[4] = __hip_atomic_fetch_add(qctr, 1u, __ATOMIC_RELAXED, __HIP_MEMORY_SCOPE_AGENT);
        __syncthreads();
        const int t = (int)MISC[4];
        if (t >= 1024) break;
        if (t < 512) sample_task<256, true>(p, lds, t >> 2, t & 3);
        else sample_task<128, false>(p, lds, (t - 512) >> 2, t & 3);
    }
}


template <int K, int KB  >
DI void tail_mma(const bf16_t* __restrict__ Arow, const bf16_t* __restrict__ Wrow, f32x4& acc) {
    for (int k0 = 0; k0 < K; k0 += 32 * KB) {
        bf16x8 a[KB], w[KB];
#pragma unroll
        for (int j = 0; j < KB; ++j) { a[j] = *(const bf16x8*)(Arow + k0 + 32 * j); w[j] = *(const bf16x8*)(Wrow + k0 + 32 * j); }
#pragma unroll
        for (int j = 0; j < KB; ++j) acc = MFMA16(w[j], a[j], acc);
    }
}
DI void tail_branch(const Params& p) {
    const int lane = threadIdx.x & 63, r = lane & 15, g = lane >> 4;
    const int gw = blockIdx.x * 8 + (threadIdx.x >> 6), NGW = gridDim.x * 8;
    const bf16_t* U = (const bf16_t*)(p.ws + WS_U); const bf16_t* W = (const bf16_t*)(p.ws + WS_WBR); const bf16_t* P = (const bf16_t*)(p.ws + WS_P); bf16_t* MRG = (bf16_t*)(p.ws + WS_MRG);
    for (int tile = gw; tile < 32 * 64; tile += NGW) {
        const int t0 = NTP + (tile >> 6) * 16, n0 = (tile & 63) * 16;
        const bf16_t* Ar = U + (size_t)(t0 + r) * UW + 8 * g; const bf16_t* Wr = W + (size_t)(n0 + r) * UW + 8 * g;
        f32x4 acc = (f32x4){0.f, 0.f, 0.f, 0.f};
        tail_mma<1024, 8>(Ar, Wr, acc);
        const u32x2 gq = *(const u32x2*)(P + (size_t)(t0 + r) * PW + C_MG + n0 + 4 * g), rq = *(const u32x2*)(P + (size_t)(t0 + r) * PW + C_MR + n0 + 4 * g);
        const float mg[4] = {bflo(gq.x), bfhi(gq.x), bflo(gq.y), bfhi(gq.y)};
        float mr[4] = {bflo(rq.x), bfhi(rq.x), bflo(rq.y), bfhi(rq.y)};
#pragma unroll
        for (int e = 0; e < 4; ++e) { mr[e] = fmaxf(mr[e], -60.f); acc[e] *= (1.0f + __expf(-mr[e])) / (1.0f + __expf(-mg[e])); }
        tail_mma<2048, 8>(Ar + 1024, Wr + 1024, acc);
        u32x2 o; o.x = pk2(acc[0] * sigmoidf_(mr[0]), acc[1] * sigmoidf_(mr[1])); o.y = pk2(acc[2] * sigmoidf_(mr[2]), acc[3] * sigmoidf_(mr[3]));
        *(u32x2*)(MRG + (size_t)(t0 + r) * DM + n0 + 4 * g) = o;
    }
}
DI void tail_out(const Params& p) {
    const int lane = threadIdx.x & 63, r = lane & 15, g = lane >> 4;
    const int gw = blockIdx.x * 8 + (threadIdx.x >> 6), NGW = gridDim.x * 8;
    const bf16_t* A = (const bf16_t*)(p.ws + WS_MRG); const bf16_t* W = (const bf16_t*)(p.ws + WS_WO); const float* ADA = (const float*)(p.ws + WS_ADA);
    float* Y = p.out + OUT_Y;
    for (int tile = gw; tile < 32 * 64; tile += NGW) {
        const int t0 = NTP + (tile >> 6) * 16, n0 = (tile & 63) * 16;
        const int row = t0 + r;
        const bf16_t* Ar = A + (size_t)row * DM + 8 * g; const bf16_t* Wr = W + (size_t)(n0 + r) * DM + 8 * g;
        f32x4 acc = (f32x4){0.f, 0.f, 0.f, 0.f};
        tail_mma<1024, 8>(Ar, Wr, acc);
        const int c = n0 + 4 * g;
        const f32x4 xv = *(const f32x4*)(p.in[1] + (size_t)(row - NTP) * DM + c);
        const f32x4 gv = *(const f32x4*)(ADA + (size_t)(NB_P + ((row - NTP) >> 2)) * 3072 + 2048 + c);
        *(f32x4*)(Y + (size_t)row * DM + c) = xv * DN_ALPHA + gv * acc;
    }
}

DI void phase5(const Params& p) {
    const int tid = threadIdx.x, lane = tid & 63, wave = tid >> 6;
    const int gw = blockIdx.x * 8 + wave, NGW = gridDim.x * 8;
    const bf16_t* P = (const bf16_t*)(p.ws + WS_P); const bf16_t* O = (const bf16_t*)(p.ws + WS_O); bf16_t* U = (bf16_t*)(p.ws + WS_U);
    const float* STAT = (const float*)(p.ws + WS_STAT);
    for (int row = gw; row < NTP; row += NGW) {
        u32x4 ovv[6], zvv[6];
#pragma unroll
        for (int j = 0; j < 6; ++j) { const int c = 8 * lane + 512 * j;
            ovv[j] = *(const u32x4*)(O + (size_t)row * UW + c);
            zvv[j] = *(const u32x4*)(P + (size_t)row * PW + (c < 1024 ? C_ZG + c : C_ZR + (c - 1024))); }
        float mu, rstd;
        {
            const f32x4 sv = *(const f32x4*)(STAT + (size_t)row * 256 + lane * 4);
            float s1 = sv[0] + sv[2], s2 = sv[1] + sv[3];
            if (lane < 32 && (lane & 7) >= 4) { s1 = 0.f; s2 = 0.f; }
            s1 += __shfl_xor(s1, 1); s2 += __shfl_xor(s2, 1); s1 += __shfl_xor(s1, 2); s2 += __shfl_xor(s2, 2); s1 += __shfl_xor(s1, 4); s2 += __shfl_xor(s2, 4);
            if (lane < 32) { mu = 0.f; rstd = rsqrtf(s2 * (1.0f / 256.f) + HN_EPS); }
            else { mu = s1 * (1.0f / 512.f); rstd = rsqrtf(fmaxf(s2 * (1.0f / 512.f) - mu * mu, 0.f) + HN_EPS); }
        }
#pragma unroll
        for (int j = 0; j < 6; ++j) {
            const int c = 8 * lane + 512 * j;
            const int hd = c < 1024 ? (c >> 8) : 4 + ((c - 1024) >> 9);
            const float m = __shfl(mu, hd * 8), rs = __shfl(rstd, hd * 8);
            const u32x4 ov = ovv[j], zv = zvv[j];
            const float* gp = c < 1024 ? p.in[11] + c : p.in[12] + (c - 1024);
            const f32x4 g0 = *(const f32x4*)gp, g1 = *(const f32x4*)(gp + 4);
            const unsigned ow[4] = {ov.x, ov.y, ov.z, ov.w}, zw[4] = {zv.x, zv.y, zv.z, zv.w}; unsigned uw[4];
#pragma unroll
            for (int q = 0; q < 4; ++q) {
                const float ga = q < 2 ? g0[2 * q] : g1[2 * q - 4], gb = q < 2 ? g0[2 * q + 1] : g1[2 * q - 3];
                const float a = (bflo(ow[q]) - m) * rs * ga * siluf_(bflo(zw[q])), bb = (bfhi(ow[q]) - m) * rs * gb * siluf_(bfhi(zw[q]));
                uw[q] = pk2(a, bb);
            }
            u32x4 o; o.x = uw[0]; o.y = uw[1]; o.z = uw[2]; o.w = uw[3];
            *(u32x4*)(U + (size_t)row * UW + c) = o;
        }
    }
}

DI void phase8(const Params& p) {
    const int tid = threadIdx.x, lane = tid & 63, wave = tid >> 6;
    const int gw = blockIdx.x * 8 + wave, NGW = gridDim.x * 8;
    float* Y = p.out + OUT_Y; const float* YST = (const float*)(p.ws + WS_YST);
    const float* lg = p.in[16]; const float* lb = p.in[17];
    f32x4 gv[4], bv[4];
#pragma unroll
    for (int j = 0; j < 4; ++j) { const int c = 4 * lane + 256 * j; gv[j] = *(const f32x4*)(lg + c); bv[j] = *(const f32x4*)(lb + c); }
    for (int row = gw; row < NTOK; row += NGW) {
        f32x4 v[4];
#pragma unroll
        for (int j = 0; j < 4; ++j) v[j] = *(const f32x4*)(Y + (size_t)row * DM + 4 * lane + 256 * j);
        float s1 = 0.f;
#pragma unroll
        for (int j = 0; j < 4; ++j) s1 += (v[j][0] + v[j][1]) + (v[j][2] + v[j][3]);
        const float mean = wave_sum(s1) * (1.0f / DM); float s2 = 0.f;
#pragma unroll
        for (int j = 0; j < 4; ++j) { v[j] = v[j] - mean; s2 += (v[j][0] * v[j][0] + v[j][1] * v[j][1]) + (v[j][2] * v[j][2] + v[j][3] * v[j][3]); }
        const float rstd = rsqrtf(wave_sum(s2) * (1.0f / DM) + LN_EPS);
#pragma unroll
        for (int j = 0; j < 4; ++j) *(f32x4*)(Y + (size_t)row * DM + 4 * lane + 256 * j) = v[j] * rstd * gv[j] + bv[j];
    }
}

constexpr int NPHASE = 9;
__global__ void __launch_bounds__(512, 2) fwd_kernel(Params p) {
    extern __shared__ __attribute__((aligned(16))) unsigned char lds_raw[];
    LAS unsigned char* lds = (LAS unsigned char*)lds_raw;
    volatile LAS unsigned* MISC = (volatile LAS unsigned*)(lds + LDS_MISC);
    const int tid = threadIdx.x;
    for (int u = tid; u < (LDS_BYTES - LDS_MISC) / 4; u += 512) ((LAS unsigned*)(lds + LDS_MISC))[u] = 0u;
    __syncthreads();
    const int lo = p.ph_lo, hi = p.ph_hi;
    XcdBarrier bar; bar.bar = (unsigned*)(p.ws + WS_CTL) + CW_BAR; bar.x = 0; bar.st = nullptr;
    if (hi - lo > 1) bar = xcd_barrier_post((unsigned*)(p.ws + WS_CTL) + CW_BAR, MISC + 8);
#ifndef PHMASK
#define PHMASK 0x1ff
#endif
#define IN(k) (((PHMASK >> (k)) & 1) && lo <= (k) && (k) < hi)
#define SEAM(k) do { if (IN(k) && IN((k) + 1)) xcd_barrier(bar); } while (0)
    unsigned char* ws = p.ws;
#ifndef REPMASK
#define REPMASK 0
#endif
#define REP(k) ((REPMASK >> (k)) & 1)
#define P2BODY do { pg8::Gemm g{(const bf16_t*)(ws + WS_H), (const bf16_t*)(ws + WS_WIN), NTOK, NIN, DM}; \
        pg8::StaticOrder S; S.init(NTOK, NIN, gridDim.x, blockIdx.x); \
        EpiIn E{(bf16_t*)(ws + WS_P), (float*)(ws + WS_LR), (const float*)(ws + WS_COS), (const float*)(ws + WS_SIN)}; \
        pg8::gemm_phase<EpiIn, pg8::StaticOrder>(lds, g, S, E); } while (0)
#define P6BODY do { tail_branch(p); pg8::Gemm g{(const bf16_t*)(ws + WS_U), (const bf16_t*)(ws + WS_WBR), NTP, DM, UW}; \
        pg8::StaticOrder S; S.init(NTP, DM, gridDim.x, blockIdx.x); \
        EpiBranch E{(const bf16_t*)(ws + WS_P), (bf16_t*)(ws + WS_MRG)}; \
        pg8::gemm_phase<EpiBranch, pg8::StaticOrder>(lds, g, S, E); } while (0)
#define P7BODY do { tail_out(p); pg8::Gemm g{(const bf16_t*)(ws + WS_MRG), (const bf16_t*)(ws + WS_WO), NTP, DM, DM}; \
        pg8::StaticOrder S; S.init(NTP, DM, gridDim.x, blockIdx.x); \
        EpiOut E{p.in[0], p.in[1], (const float*)(ws + WS_ADA), p.out + OUT_Y, (float*)(ws + WS_YST)}; \
        pg8::gemm_phase<EpiOut, pg8::StaticOrder>(lds, g, S, E); } while (0)
    if (IN(0)) { phase0(p, lds); if (REP(0)) { xcd_barrier(bar); phase0(p, lds); } } SEAM(0);
    if (IN(1)) { phase1(p); if (REP(1)) { xcd_barrier(bar); phase1(p); } } SEAM(1);
    if (IN(2)) { P2BODY; if (REP(2)) { xcd_barrier(bar); P2BODY; } } SEAM(2);
    if (IN(3)) { phase3(p, lds); if (REP(3)) { xcd_barrier(bar); P2BODY; xcd_barrier(bar); phase3(p, lds); } } SEAM(3);
    if (IN(4)) { phase4(p, lds); if (REP(4)) { xcd_barrier(bar); phase4(p, lds); } } SEAM(4);
    if (IN(5)) { phase5(p); if (REP(5)) { xcd_barrier(bar); phase5(p); } } SEAM(5);
    if (IN(6)) { P6BODY; if (REP(6)) { xcd_barrier(bar); P6BODY; } } SEAM(6);
    if (IN(7)) { P7BODY; if (REP(7)) { xcd_barrier(bar); P7BODY; } } SEAM(7);
    if (IN(8)) { phase8(p); if (REP(8)) { xcd_barrier(bar); P7BODY; xcd_barrier(bar); phase8(p); } }
}

#ifndef N_LAUNCH_SPLIT
#define N_LAUNCH_SPLIT 0
#endif

extern "C" void kernel_launch(void* const* d_in, const int* in_sizes, int n_in, void* d_out, int out_size, void* d_ws, size_t ws_size, hipStream_t stream) {
    static int ready = 0;
    if (!ready) {
        if (n_in != 18 || ws_size < WS_END) { fprintf(stderr, "kernel_launch: unexpected n_in %d or ws_size %zu (need %zu)\n", n_in, ws_size, (size_t)WS_END); }
        if (hipFuncSetAttribute((const void*)fwd_kernel, hipFuncAttributeMaxDynamicSharedMemorySize, LDS_BYTES) != hipSuccess) fprintf(stderr, "kernel_launch: hipFuncSetAttribute failed\n");
        ready = 1;
    }
    Params p; memset(&p, 0, sizeof(p));
    for (int i = 0; i < 18; ++i) p.in[i] = (const float*)d_in[i];
    p.out = (float*)d_out; p.ws = (unsigned char*)d_ws;
    (void)hipMemsetAsync((char*)d_ws + WS_CTL, 0, 1 * MiB, stream);
#if N_LAUNCH_SPLIT
    for (int k = 0; k < NPHASE; ++k) { p.ph_lo = k; p.ph_hi = k + 1; hipLaunchKernelGGL(fwd_kernel, dim3(256), dim3(512), LDS_BYTES, stream, p); }
#else
    p.ph_lo = 0; p.ph_hi = NPHASE; hipLaunchKernelGGL(fwd_kernel, dim3(256), dim3(512), LDS_BYTES, stream, p);
#endif
    hipError_t e = hipGetLastError();
    if (e != hipSuccess) fprintf(stderr, "kernel_launch: launch failed: %s\n", hipGetErrorString(e));
}
```

```cpp
#include <hip/hip_runtime.h>
#include <cstdio>
#include <cstdint>
#include <cstring>

#define LAS __attribute__((address_space(3)))
#define DI __device__ __forceinline__
typedef unsigned short bf16_t;
typedef short bf16x8 __attribute__((ext_vector_type(8)));
typedef float f32x4 __attribute__((ext_vector_type(4)));
typedef unsigned u32x4 __attribute__((ext_vector_type(4)));
typedef unsigned u32x2 __attribute__((ext_vector_type(2)));

constexpr int DM = 1024;
constexpr int NTP = 16384, NTS = 512, NTOK = NTP + NTS, TP = 2048;
constexpr int NB_P = 8, NB_S = 128;
constexpr int PW = 11264;
constexpr int NIN = 11520;
constexpr int C_QG = 0, C_KG = 512, C_VG = 1024, C_ZG = 2048, C_QR = 3072, C_KR = 4096, C_VR = 5120, C_ZR = 7168, C_MG = 9216, C_MR = 10240;
constexpr int UW = 3072;
constexpr int CH = 64;
constexpr int NCHP = NTP / CH;
constexpr float LN_EPS = 1e-5f, HN_EPS = 1e-5f;
constexpr float DN_ALPHA = 1.189207115002721f;

constexpr size_t OUT_Y = 0, OUT_SGP = 17301504, OUT_SRP = 18350080, OUT_SGS = 22544384, OUT_SRS = 39321600;

constexpr size_t MiB = 1024 * 1024;
constexpr size_t WS_CTL = 0;
constexpr size_t WS_ADA = 1 * MiB;
constexpr size_t WS_COS = 3 * MiB;
constexpr size_t WS_SIN = 5 * MiB;
constexpr size_t WS_LR = 7 * MiB;
constexpr size_t WS_LAM = 9 * MiB;
constexpr size_t WS_YST = 10 * MiB;
constexpr size_t WS_STAT = 13 * MiB;
constexpr size_t WS_WIN = 30 * MiB;
constexpr size_t WS_WBR = 54 * MiB;
constexpr size_t WS_WO = 61 * MiB;
constexpr size_t WS_H = 64 * MiB;
constexpr size_t WS_MRG = 98 * MiB;
constexpr size_t WS_O = 132 * MiB;
constexpr size_t WS_U = 232 * MiB;
constexpr size_t WS_P = 332 * MiB;
constexpr size_t WS_END = 700 * MiB;
constexpr int CW_BAR = 4096;

constexpr int LDS_MISC = 147456;
constexpr int LDS_BYTES = 147456 + 1024;

struct Params {
    const float* in[18];
    float* out;
    unsigned char* ws;
    int ph_lo, ph_hi;
};

DI unsigned f2bf(float f) { unsigned u = __builtin_bit_cast(unsigned, f); return (u + 0x7fffu + ((u >> 16) & 1u)) >> 16; }
DI unsigned pk2(float lo, float hi) { return f2bf(lo) | (f2bf(hi) << 16); }
DI float bflo(unsigned w) { return __builtin_bit_cast(float, w << 16); }
DI float bfhi(unsigned w) { return __builtin_bit_cast(float, w & 0xffff0000u); }
DI float bf1(bf16_t b) { return __builtin_bit_cast(float, ((unsigned)b) << 16); }
DI float wave_sum(float v) {
#pragma unroll
    for (int o = 1; o < 64; o <<= 1) v += __shfl_xor(v, o);
    return v;
}
DI float sigmoidf_(float x) { return 1.0f / (1.0f + __expf(-x)); }
DI float siluf_(float x) { return x / (1.0f + __expf(-x)); }
#define LDS_WAIT() asm volatile("s_waitcnt lgkmcnt(0)" ::: "memory")

namespace pg8 {
constexpr int BM = 256, BK = 64, HALF = 128, HTB = HALF * BK * 2, STAGE_BYTES = 8 * HTB, NXCD = 8, WGM = 8;
DI int lds_byte(int r, int c) { const int st = (r >> 4) * 2 + (c >> 5), rr = r & 15, cc = c & 31, ob = rr * 64 + cc * 2; return st * 1024 + (ob ^ (((ob >> 9) & 1) << 5)); }
DI void stage_rc(int b, int& R, int& C) { const int st = b / 1024, sb = b % 1024, swz = sb ^ (((sb >> 9) & 1) << 5); R = (st >> 1) * 16 + swz / 64; C = (st & 1) * 32 + (swz % 64) / 2; }
DI int perm32(int rho) { const int n = rho >> 4, i = rho & 15; return 8 * (i >> 2) + 4 * n + (i & 3); }
struct Unit { int pm, pn; };
struct Gemm { const bf16_t* A; const bf16_t* Bt; int M, N, K; };
struct StaticOrder {
    int nM, nN, nwg, G, c;
    DI void init(int M, int N, int G_, int c_) { nM = M / BM; nN = N / BM; nwg = nM * nN; G = G_; c = c_; }
    DI bool next(int i, Unit& u) const {
        const long L = (long)i * G + c; if (L >= nwg) return false;
        int wgid = (int)L; { const int q = nwg / NXCD, r = nwg % NXCD, xcd = wgid % NXCD, off = wgid / NXCD; wgid = (xcd < r ? xcd * (q + 1) : r * (q + 1) + (xcd - r) * q) + off; }
        const int nig = WGM * nN, gid = wgid / nig, fm = gid * WGM, gsz = (nM - fm) < WGM ? (nM - fm) : WGM;
        u.pm = fm + ((wgid % nig) % gsz); u.pn = (wgid % nig) / gsz; return true;
    }
    DI void a_ready(const Unit&) const {}
    DI void done(const Unit&) const {}
};

template <class Epi, class Sched>
DI void gemm_phase(LAS unsigned char* lds, const Gemm g, const Sched& S, const Epi& E) {
    const int tid = threadIdx.x, wid = __builtin_amdgcn_readfirstlane(tid >> 6), lane = tid & 63, wr = wid >> 2, wc = wid & 3, fr = lane & 15, fq = lane >> 4;
    const int K = g.K, nt = K / BK;
    unsigned voffA[2], voffB[2];
#pragma unroll
    for (int i = 0; i < 2; ++i) { int R, C; stage_rc(tid * 16 + i * 8192, R, C); const int Rb = Epi::PERM ? ((R & ~31) + perm32(R & 31)) : R;
        voffA[i] = (unsigned)(R * K + C) * 2u; voffB[i] = (unsigned)(Rb * K + C) * 2u; }
    const size_t kstep = (size_t)(BK * 2);
    const size_t hstep = (size_t)HALF * K * 2;
    const size_t tstep = 2 * hstep;
    const unsigned ldsw = (unsigned)wid * 1024u;
    const int aoff = lds_byte(wr * 64 + fr, fq * 8), boff = lds_byte(wc * 32 + fr, fq * 8);
#define PG8_SA(b, h) (((b) * 2 + (h)) * HTB)
#define PG8_SB(b, h) ((4 + (b) * 2 + (h)) * HTB)
#define PG8_STAGE(bufoff, gbase, voff) do { _Pragma("unroll") for (int _i = 0; _i < 2; ++_i) \
        __builtin_amdgcn_global_load_lds((const unsigned*)((const char*)(gbase) + (voff)[_i]), (LAS unsigned*)(lds + (bufoff) + ldsw + _i * 8192), 16, 0, 0); } while (0)
#define PG8_LDA(dst, b, h) do { _Pragma("unroll") for (int m = 0; m < 4; ++m) _Pragma("unroll") for (int k = 0; k < 2; ++k) dst[m][k] = *(const LAS bf16x8*)(lds + PG8_SA(b, h) + aoff + m * 2048 + k * 1024); } while (0)
#define PG8_LDB(dst, b, h) do { _Pragma("unroll") for (int n = 0; n < 2; ++n) _Pragma("unroll") for (int k = 0; k < 2; ++k) dst[n][k] = *(const LAS bf16x8*)(lds + PG8_SB(b, h) + boff + n * 2048 + k * 1024); } while (0)
#define PG8_MMA(ai, bj, At, Bt) do { __builtin_amdgcn_s_setprio(1); _Pragma("unroll") for (int m = 0; m < 4; ++m) _Pragma("unroll") for (int n = 0; n < 2; ++n) _Pragma("unroll") for (int k = 0; k < 2; ++k) \
        acc[ai][bj][m][n] = __builtin_amdgcn_mfma_f32_16x16x32_bf16(Bt[n][k], At[m][k], acc[ai][bj][m][n], 0, 0, 0); __builtin_amdgcn_s_setprio(0); } while (0)
#define PG8_WAIT_V(n) asm volatile("s_waitcnt vmcnt(" #n ")" ::: "memory")
#define PG8_WAIT_L(n) asm volatile("s_waitcnt lgkmcnt(" #n ")" ::: "memory")
#define PG8_BAR __builtin_amdgcn_s_barrier()
#define PG8_SCHED __builtin_amdgcn_sched_barrier(0)
    Unit cur, nxt; int ui = 0;
    if (!S.next(0, cur)) return;
    f32x4 acc[2][2][4][2];
#pragma unroll
    for (int a = 0; a < 2; ++a)
#pragma unroll
        for (int b = 0; b < 2; ++b)
#pragma unroll
            for (int m = 0; m < 4; ++m)
#pragma unroll
                for (int n = 0; n < 2; ++n) acc[a][b][m][n] = (f32x4){0.f, 0.f, 0.f, 0.f};
    bf16x8 At[4][2], B0[2][2], B1[2][2];
    const char* cA = (const char*)g.A + (size_t)cur.pm * tstep; const char* cB = (const char*)g.Bt + (size_t)cur.pn * tstep;
    S.a_ready(cur);
    PG8_STAGE(PG8_SB(0, 0), cB, voffB); PG8_STAGE(PG8_SA(0, 0), cA, voffA); PG8_STAGE(PG8_SB(0, 1), cB + hstep, voffB); PG8_STAGE(PG8_SA(0, 1), cA + hstep, voffA);
    if (wr == 1) PG8_BAR;
    PG8_WAIT_V(4); PG8_BAR;
    PG8_STAGE(PG8_SB(1, 0), cB + kstep, voffB); PG8_STAGE(PG8_SA(1, 0), cA + kstep, voffA); PG8_STAGE(PG8_SB(1, 1), cB + hstep + kstep, voffB);
    PG8_WAIT_V(6); PG8_BAR;
    for (;;) {
        const bool has_next = S.next(ui + 1, nxt);
        const char* nA = has_next ? (const char*)g.A + (size_t)nxt.pm * tstep : cA; const char* nB = has_next ? (const char*)g.Bt + (size_t)nxt.pn * tstep : cB;
        for (int t = 0; t < nt; t += 2) {
            const bool last = (t == nt - 2);
            const char* a1 = cA + (size_t)(t + 1) * kstep;
            const char* a2 = last ? nA : cA + (size_t)(t + 2) * kstep; const char* b2 = last ? nB : cB + (size_t)(t + 2) * kstep;
            const char* a3 = a2 + kstep; const char* b3 = b2 + kstep;
            if (last && has_next) S.a_ready(nxt);
            if constexpr (Epi::MID_T > 0) { if (t == Epi::MID_T) E.mid(acc, cur, wr, wc, fr, fq); }
            PG8_LDB(B0, 0, 0); PG8_SCHED; PG8_LDA(At, 0, 0); PG8_STAGE(PG8_SA(1, 1), a1 + hstep, voffA);
            PG8_WAIT_L(8); PG8_BAR; PG8_WAIT_L(0); PG8_MMA(0, 0, At, B0); PG8_BAR; PG8_SCHED;
            PG8_LDB(B1, 0, 1); PG8_STAGE(PG8_SB(0, 0), b2, voffB);
            PG8_BAR; PG8_WAIT_L(0); PG8_MMA(0, 1, At, B1); PG8_BAR;
            PG8_LDA(At, 0, 1); PG8_STAGE(PG8_SA(0, 0), a2, voffA);
            PG8_BAR; PG8_WAIT_L(0); PG8_MMA(1, 0, At, B0); PG8_BAR; PG8_SCHED;
            PG8_STAGE(PG8_SB(0, 1), b2 + hstep, voffB);
            PG8_WAIT_V(6); PG8_BAR; PG8_MMA(1, 1, At, B1); PG8_BAR;
            PG8_LDB(B0, 1, 0); PG8_SCHED; PG8_LDA(At, 1, 0); PG8_STAGE(PG8_SA(0, 1), a2 + hstep, voffA);
            PG8_WAIT_L(8); PG8_BAR; PG8_WAIT_L(0); PG8_MMA(0, 0, At, B0); PG8_BAR; PG8_SCHED;
            PG8_LDB(B1, 1, 1); PG8_STAGE(PG8_SB(1, 0), b3, voffB);
            PG8_BAR; PG8_WAIT_L(0); PG8_MMA(0, 1, At, B1); PG8_BAR;
            PG8_LDA(At, 1, 1); PG8_STAGE(PG8_SA(1, 0), a3, voffA);
            PG8_BAR; PG8_WAIT_L(0); PG8_MMA(1, 0, At, B0); PG8_BAR; PG8_SCHED;
            PG8_STAGE(PG8_SB(1, 1), b3 + hstep, voffB);
            PG8_WAIT_V(6); PG8_BAR; PG8_MMA(1, 1, At, B1); PG8_BAR;
        }
        E(acc, cur, wr, wc, fr, fq); S.done(cur);
        if (!has_next) break;
#pragma unroll
        for (int a = 0; a < 2; ++a)
#pragma unroll
            for (int b = 0; b < 2; ++b)
#pragma unroll
                for (int m = 0; m < 4; ++m)
#pragma unroll
                    for (int n = 0; n < 2; ++n) acc[a][b][m][n] = (f32x4){0.f, 0.f, 0.f, 0.f};
        cur = nxt; cA = nA; cB = nB; ++ui;
    }
    PG8_WAIT_V(0);
    if (wr == 0) PG8_BAR;
    PG8_BAR;
#undef PG8_SA
#undef PG8_SB
#undef PG8_STAGE
#undef PG8_LDA
#undef PG8_LDB
#undef PG8_MMA
#undef PG8_WAIT_V
#undef PG8_WAIT_L
#undef PG8_BAR
#undef PG8_SCHED
}
}

typedef f32x4 AccT[2][2][4][2];

struct EpiIn {
    static constexpr bool PERM = true; static constexpr int MID_T = 0;
    bf16_t* P; float* LR; const float* COS; const float* SIN;
    DI void mid(AccT&, const pg8::Unit&, int, int, int, int) const {}
    DI void operator()(const AccT& acc, const pg8::Unit& u, int wr, int wc, int fr, int fq) const {
        const int pn = u.pn;
        const int row0 = u.pm * 256 + wr * 64 + fr;
        if (pn == 44) {
            if (wc == 0 && fq < 2) {
#pragma unroll
                for (int ai = 0; ai < 2; ++ai)
#pragma unroll
                    for (int m = 0; m < 4; ++m) { const int row = row0 + ai * 128 + m * 16; float* o = LR + (size_t)row * 16 + 8 * fq;
                        *(f32x4*)(o) = acc[ai][0][m][0]; *(f32x4*)(o + 4) = acc[ai][0][m][1]; }
            }
            return;
        }
        const bool rot = (pn >= 12 && pn < 20), isk = (pn >= 16 && pn < 20);
        const int cl = wc * 32 + 8 * fq;
        float l2g = 0.f;
        if (isk) { const int h = pn - 16; l2g = __log2f(1.0f - exp2f(-5.0f - (float)h)); }
#pragma unroll
        for (int ai = 0; ai < 2; ++ai)
#pragma unroll
            for (int m = 0; m < 4; ++m) {
                const int row = row0 + ai * 128 + m * 16;
                f32x4 v00 = acc[ai][0][m][0], v01 = acc[ai][0][m][1], v10 = acc[ai][1][m][0], v11 = acc[ai][1][m][1];
                if (rot) {
                    const int ti = row < NTP ? (row & (TP - 1)) : (TP + (row & 3));
                    const f32x4 c0 = *(const f32x4*)(COS + (size_t)ti * 128 + cl), c1 = *(const f32x4*)(COS + (size_t)ti * 128 + cl + 4);
                    const f32x4 s0 = *(const f32x4*)(SIN + (size_t)ti * 128 + cl), s1 = *(const f32x4*)(SIN + (size_t)ti * 128 + cl + 4);
                    float sc = 1.0f;
                    if (isk) { const int sp = row < NTP ? (row & (CH - 1)) : (row & 3); sc = 0.0625f * exp2f(-(float)(sp + 1) * l2g); }
                    const f32x4 a0 = (v00 * c0 - v10 * s0) * sc, a1 = (v01 * c1 - v11 * s1) * sc;
                    const f32x4 b0 = (v00 * s0 + v10 * c0) * sc, b1 = (v01 * s1 + v11 * c1) * sc;
                    v00 = a0; v01 = a1; v10 = b0; v11 = b1;
                }
                bf16_t* rowp = P + (size_t)row * PW + pn * 256 + cl;
                u32x4 w; w.x = pk2(v00[0], v00[1]); w.y = pk2(v00[2], v00[3]); w.z = pk2(v01[0], v01[1]); w.w = pk2(v01[2], v01[3]);
                *(u32x4*)(rowp) = w;
                w.x = pk2(v10[0], v10[1]); w.y = pk2(v10[2], v10[3]); w.z = pk2(v11[0], v11[1]); w.w = pk2(v11[2], v11[3]);
                *(u32x4*)(rowp + 128) = w;
            }
    }
};

struct EpiBranch {
    static constexpr bool PERM = true; static constexpr int MID_T = 16;
    const bf16_t* P; bf16_t* MRG;
    DI void mid(AccT& acc, const pg8::Unit& u, int wr, int wc, int fr, int fq) const {
        int row0 = u.pm * 256 + wr * 64 + fr, cl = u.pn * 256 + wc * 32 + 8 * fq;
        asm volatile("" : "+v"(row0), "+v"(cl));
#pragma unroll
        for (int ai = 0; ai < 2; ++ai)
#pragma unroll
            for (int m = 0; m < 4; ++m) { const int row = row0 + ai * 128 + m * 16;
#pragma unroll
                for (int bj = 0; bj < 2; ++bj) {
                    const u32x4 g = *(const u32x4*)(P + (size_t)row * PW + C_MG + cl + bj * 128);
                    const u32x4 r = *(const u32x4*)(P + (size_t)row * PW + C_MR + cl + bj * 128);
                    const unsigned gw[4] = {g.x, g.y, g.z, g.w}, rw[4] = {r.x, r.y, r.z, r.w};
#pragma unroll
                    for (int j = 0; j < 4; ++j) {
                        const float mg0 = bflo(gw[j]), mg1 = bfhi(gw[j]); float mr0 = bflo(rw[j]), mr1 = bfhi(rw[j]);
                        mr0 = fmaxf(mr0, -60.f); mr1 = fmaxf(mr1, -60.f);
                        const float q0 = (1.0f + __expf(-mr0)) / (1.0f + __expf(-mg0)), q1 = (1.0f + __expf(-mr1)) / (1.0f + __expf(-mg1));
                        acc[ai][bj][m][j >> 1][(j & 1) * 2] *= q0; acc[ai][bj][m][j >> 1][(j & 1) * 2 + 1] *= q1;
                    }
                    asm volatile("" ::: "memory");
                } }
    }
    DI void operator()(const AccT& acc, const pg8::Unit& u, int wr, int wc, int fr, int fq) const {
        const int row0 = u.pm * 256 + wr * 64 + fr, cl = u.pn * 256 + wc * 32 + 8 * fq;
#pragma unroll
        for (int ai = 0; ai < 2; ++ai)
#pragma unroll
            for (int m = 0; m < 4; ++m) { const int row = row0 + ai * 128 + m * 16;
#pragma unroll
                for (int bj = 0; bj < 2; ++bj) {
                    const u32x4 r = *(const u32x4*)(P + (size_t)row * PW + C_MR + cl + bj * 128);
                    const unsigned rw[4] = {r.x, r.y, r.z, r.w}; unsigned ow[4];
#pragma unroll
                    for (int j = 0; j < 4; ++j) {
                        const float mr0 = fmaxf(bflo(rw[j]), -60.f), mr1 = fmaxf(bfhi(rw[j]), -60.f);
                        const float o0 = acc[ai][bj][m][j >> 1][(j & 1) * 2] * sigmoidf_(mr0), o1 = acc[ai][bj][m][j >> 1][(j & 1) * 2 + 1] * sigmoidf_(mr1);
                        ow[j] = pk2(o0, o1);
                    }
                    u32x4 w; w.x = ow[0]; w.y = ow[1]; w.z = ow[2]; w.w = ow[3];
                    *(u32x4*)(MRG + (size_t)row * DM + cl + bj * 128) = w;
                } }
    }
};

struct EpiOut {
    static constexpr bool PERM = false; static constexpr int MID_T = 0;
    const float* xp; const float* xs; const float* ADA; float* Y; float* YST;
    DI void mid(AccT&, const pg8::Unit&, int, int, int, int) const {}
    DI void operator()(const AccT& acc, const pg8::Unit& u, int wr, int wc, int fr, int fq) const {
        const int row0 = u.pm * 256 + wr * 64 + fr, col0 = u.pn * 256 + wc * 32 + 4 * fq;
#pragma unroll
        for (int ai = 0; ai < 2; ++ai)
#pragma unroll
            for (int m = 0; m < 4; ++m) { const int row = row0 + ai * 128 + m * 16;
                const float* xr = row < NTP ? xp + (size_t)row * DM : xs + (size_t)(row - NTP) * DM;
                const int bidx = row < NTP ? (row >> 11) : (NB_P + ((row - NTP) >> 2));
                const float* gr = ADA + (size_t)bidx * 3072 + 2048;
#pragma unroll
                for (int bj = 0; bj < 2; ++bj)
#pragma unroll
                    for (int n = 0; n < 2; ++n) { const int c = col0 + bj * 128 + n * 16;
                        const f32x4 xv = *(const f32x4*)(xr + c), gv = *(const f32x4*)(gr + c);
                        const f32x4 v = xv * DN_ALPHA + gv * acc[ai][bj][m][n];
                        *(f32x4*)(Y + (size_t)row * DM + c) = v; }
            }
    }
};

#define XB_TMO      128
#define XB_XCNT(j)  (256  + 64 * (j))
#define XB_XSUB(j)  (1280 + 64 * (j))
#define XB_XGEN(j)  (2304 + 64 * (j))
#define XB_TOP      3328
#define XB_TOPGEN   3392
#define XCD_BAR_WORDS 3456
#define XB_SPIN_CAP (1u << 18)
DI unsigned xb_ld(unsigned* p)              { return __hip_atomic_load(p, __ATOMIC_RELAXED, __HIP_MEMORY_SCOPE_AGENT); }
DI unsigned xb_add(unsigned* p, unsigned v) { return __hip_atomic_fetch_add(p, v, __ATOMIC_RELAXED, __HIP_MEMORY_SCOPE_AGENT); }
DI unsigned xb_xcc_id() { return (unsigned)__builtin_amdgcn_s_getreg((3 << 11) | 20) & 0xFu; }
#define XB_SPIN(cond, bar) do { unsigned _sp = 0; while (cond) { __builtin_amdgcn_s_sleep(1); \
    if ((++_sp & 255u) == 0u) { if (xb_ld(&(bar)[XB_TMO])) break; if (_sp > XB_SPIN_CAP) { atomicAdd(&(bar)[XB_TMO], 1u); break; } } } } while (0)
struct XcdBarrier { unsigned* bar; unsigned x; volatile LAS unsigned* st; };
DI XcdBarrier xcd_barrier_post(unsigned* bar, volatile LAS unsigned* st) {
    XcdBarrier b; b.bar = bar; b.x = xb_xcc_id(); b.st = st;
    if (threadIdx.x == 0) (void)xb_add(&bar[XB_XCNT(b.x)], 1u);
    return b;
}
DI void xcd_barrier_complete(unsigned* bar, unsigned x, unsigned& nloc, unsigned& nx) {
    const unsigned G = gridDim.x * gridDim.y * gridDim.z;
    unsigned sum, cnt, mine, sp = 0u;
    for (;;) {
        sum = 0u; cnt = 0u; mine = 0u;
#pragma unroll
        for (unsigned j = 0; j < 16; ++j) { const unsigned c = xb_ld(&bar[XB_XCNT(j)]); sum += c; cnt += (c > 0u) ? 1u : 0u; mine = (j == x) ? c : mine; }
        if (sum == G) break;
        __builtin_amdgcn_s_sleep(1);
        if ((++sp & 255u) == 0u) { if (xb_ld(&bar[XB_TMO])) break; if (sp > XB_SPIN_CAP) { atomicAdd(&bar[XB_TMO], 1u); break; } }
    }
    nloc = mine > 0u ? mine : 1u; nx = cnt > 0u ? cnt : 1u;
}
DI void xcd_barrier(const XcdBarrier& b) {
    asm volatile("s_waitcnt vmcnt(0)" ::: "memory");
    __syncthreads();
    if (threadIdx.x == 0) {
        unsigned* bar = b.bar;
        __builtin_amdgcn_s_waitcnt(0);
        unsigned nloc = b.st[0], nx = b.st[1];
        if (nloc == 0u) { xcd_barrier_complete(bar, b.x, nloc, nx); b.st[0] = nloc; b.st[1] = nx; }
        const unsigned old = xb_add(&bar[XB_XSUB(b.x)], 1u);
        const unsigned gen = old / nloc;
        if (old + 1u == (gen + 1u) * nloc) {
            __builtin_amdgcn_fence(__ATOMIC_RELEASE, "agent");
            asm volatile("s_waitcnt vmcnt(0)" ::: "memory");
            const unsigned og = xb_add(&bar[XB_TOP], 1u);
            const unsigned tg = og / nx;
            if (og + 1u == (tg + 1u) * nx) xb_add(&bar[XB_TOPGEN], 1u);
            else XB_SPIN(xb_ld(&bar[XB_TOPGEN]) == tg, bar);
            __builtin_amdgcn_fence(__ATOMIC_ACQUIRE, "agent");
            xb_add(&bar[XB_XGEN(b.x)], 1u);
            asm volatile("s_waitcnt vmcnt(0)" ::: "memory");
        } else {
            XB_SPIN(xb_ld(&bar[XB_XGEN(b.x)]) == gen, bar);
            __builtin_amdgcn_fence(__ATOMIC_ACQUIRE, "agent");
            asm volatile("s_waitcnt vmcnt(0)" ::: "memory");
        }
    }
    __syncthreads();
}

template <int MODE>
DI void transpose_item(const float* W, int N, bf16_t* WT, int ldk, int koff, LAS float* scr, int kb, int nb, int lane) {
    const int k0 = 64 * kb, n0 = 32 * nb;
    const int n = n0 + (lane & 31);
    int src = n;
    if (MODE == 1) src = n < 3072 ? n : (n < 11264 ? n + 16 : (n < 11280 ? 3072 + (n - 11264) : -1));
    float tv[32];
#pragma unroll
    for (int i = 0; i < 32; ++i) { const int kk = 2 * i + (lane >> 5); tv[i] = src >= 0 ? W[(size_t)(k0 + kk) * N + src] : 0.f; }
#pragma unroll
    for (int i = 0; i < 32; ++i) { const int kk = 2 * i + (lane >> 5); scr[kk * 33 + (lane & 31)] = tv[i]; }
    LDS_WAIT(); asm volatile("" ::: "memory");
    const int c = lane & 7;
#pragma unroll
    for (int j = 0; j < 4; ++j) { const int nn = (lane >> 3) + 8 * j; const LAS float* s = scr + (8 * c) * 33 + nn;
        u32x4 o; o.x = pk2(s[0 * 33], s[1 * 33]); o.y = pk2(s[2 * 33], s[3 * 33]); o.z = pk2(s[4 * 33], s[5 * 33]); o.w = pk2(s[6 * 33], s[7 * 33]);
        *(u32x4*)(WT + (size_t)(n0 + nn) * ldk + koff + k0 + 8 * c) = o; }
    LDS_WAIT(); asm volatile("" ::: "memory");
}

DI void phase0b(const Params& p, LAS unsigned char* lds) {
    const int tid = threadIdx.x, lane = tid & 63, wave = __builtin_amdgcn_readfirstlane(tid >> 6);
    const int G = gridDim.x, bx = blockIdx.x;
    unsigned char* ws = p.ws;
    {
        LAS float* scr = (LAS float*)(lds + wave * 16384);
        const int gw = bx * 8 + wave, NGW = G * 8;
        constexpr int I_IN = 16 * (NIN / 32), I_BG = 16 * 32, I_BR = 32 * 32, I_O = 16 * 32;
        constexpr int NIT = I_IN + I_BG + I_BR + I_O;
        for (int it = gw; it < NIT; it += NGW) {
            int r = it;
            if (r < I_IN) { transpose_item<1>(p.in[8], 11280, (bf16_t*)(ws + WS_WIN), 1024, 0, scr, r / (NIN / 32), r % (NIN / 32), lane); continue; } r -= I_IN;
            if (r < I_BG) { transpose_item<0>(p.in[13], 1024, (bf16_t*)(ws + WS_WBR), 3072, 0, scr, r / 32, r % 32, lane); continue; } r -= I_BG;
            if (r < I_BR) { transpose_item<0>(p.in[14], 1024, (bf16_t*)(ws + WS_WBR), 3072, 1024, scr, r / 32, r % 32, lane); continue; } r -= I_BR;
            transpose_item<0>(p.in[15], 1024, (bf16_t*)(ws + WS_WO), 1024, 0, scr, r / 32, r % 32, lane);
        }
    }
    {
        float* COS = (float*)(ws + WS_COS); float* SIN = (float*)(ws + WS_SIN);
        for (int i = bx * 512 + tid; i < 2052 * 128; i += G * 512) {
            const int ti = i >> 7, j = i & 127;
            const double pos = ti < TP ? (double)ti : (double)(16384 + (ti - TP));
            const double inv = exp(-(double)j * (9.210340371976184 / 128.0));
            const double ang = pos * inv;
            const double red = ang - 6.283185307179586476925 * rint(ang * 0.15915494309189533577);
            float sn, cs_; sincosf((float)red, &sn, &cs_);
            COS[i] = cs_; SIN[i] = sn;
        }
    }
    __syncthreads();
}

DI void phase0(const Params& p, LAS unsigned char* lds) {
    const int tid = threadIdx.x, lane = tid & 63, wave = __builtin_amdgcn_readfirstlane(tid >> 6);
    const int G = gridDim.x, bx = blockIdx.x;
    unsigned char* ws = p.ws;
    {
        const float* wada = p.in[6]; const float* bada = p.in[7];
        float* ADA = (float*)(ws + WS_ADA);
        LAS float* cs = (LAS float*)lds;
        LAS float* red = (LAS float*)(lds + 65536);
        for (int task = bx; task < 9 * 48; task += G) {
            const int rg = task / 48, cb = task % 48, r0 = rg * 16, j0 = cb * 64;
            __syncthreads();
            for (int i = tid; i < 16 * 256; i += 512) { const int r = r0 + (i >> 8), k = (i & 255) * 4;
                f32x4 v = (f32x4){0.f, 0.f, 0.f, 0.f}; if (r < 136) v = r < NB_P ? *(const f32x4*)(p.in[4] + (size_t)r * 1024 + k) : *(const f32x4*)(p.in[5] + (size_t)(r - NB_P) * 1024 + k);
                *(LAS f32x4*)(cs + (i >> 8) * 1024 + k) = v; }
            __syncthreads();
            float a[16];
#pragma unroll
            for (int r = 0; r < 16; ++r) a[r] = 0.f;
            const int kbeg = wave * 128;
            for (int kb2 = kbeg; kb2 < kbeg + 128; kb2 += 32) {
                float wv[32];
#pragma unroll
                for (int q = 0; q < 32; ++q) wv[q] = wada[(size_t)(kb2 + q) * 3072 + j0 + lane];
#pragma unroll
                for (int q = 0; q < 32; q += 4) {
#pragma unroll
                    for (int r = 0; r < 16; ++r) { const f32x4 cv = *(const LAS f32x4*)(cs + r * 1024 + kb2 + q);
                        a[r] += cv[0] * wv[q] + cv[1] * wv[q + 1] + cv[2] * wv[q + 2] + cv[3] * wv[q + 3]; }
                    asm volatile("" ::: "memory");
                }
            }
#pragma unroll
            for (int r = 0; r < 16; ++r) red[(wave * 16 + r) * 64 + lane] = a[r];
            __syncthreads();
            for (int i = tid; i < 16 * 64; i += 512) { const int r = i >> 6, j = i & 63; float s = 0.f;
#pragma unroll
                for (int w = 0; w < 8; ++w) s += red[(w * 16 + r) * 64 + j];
                if (r0 + r < 136) ADA[(size_t)(r0 + r) * 3072 + j0 + j] = s + bada[j0 + j]; }
        }
        __syncthreads();
    }
}

DI void phase1(const Params& p) {
    const int tid = threadIdx.x, lane = tid & 63, wave = tid >> 6;
    const int gw = blockIdx.x * 8 + wave, NGW = gridDim.x * 8;
    const float* ADA = (const float*)(p.ws + WS_ADA); bf16_t* H = (bf16_t*)(p.ws + WS_H);
    for (int row = gw; row < NTOK; row += NGW) {
        const float* xr = row < NTP ? p.in[0] + (size_t)row * DM : p.in[1] + (size_t)(row - NTP) * DM;
        const int bidx = row < NTP ? (row >> 11) : (NB_P + ((row - NTP) >> 2));
        const float* ar = ADA + (size_t)bidx * 3072;
#pragma unroll
        for (int j = 0; j < 4; ++j) { const int c = 4 * lane + 256 * j;
            const f32x4 xv = *(const f32x4*)(xr + c), sh = *(const f32x4*)(ar + c), sc = *(const f32x4*)(ar + 1024 + c);
            const f32x4 hv = xv * (sc + 1.0f) + sh;
            u32x2 w; w.x = pk2(hv[0], hv[1]); w.y = pk2(hv[2], hv[3]);
            *(u32x2*)(H + (size_t)row * DM + c) = w; }
    }
}

DI void phase3(const Params& p, LAS unsigned char* lds) {
    const int tid = threadIdx.x;
    bf16_t* P = (bf16_t*)(p.ws + WS_P); const float* LR = (const float*)(p.ws + WS_LR); float* LAM = (float*)(p.ws + WS_LAM);
    const float* wl = p.in[9]; const float* bl = p.in[10];
    LAS float* lrs = (LAS float*)lds;
    LAS float* ebuf = (LAS float*)(lds + 4096);
    float w[16];
#pragma unroll
    for (int j = 0; j < 16; ++j) w[j] = wl[j * 512 + tid];
    const float bias = bl[tid];
    for (int item = blockIdx.x; item < NCHP + NB_S; item += gridDim.x) {
        const int tok0 = item < NCHP ? item * CH : NTP + (item - NCHP) * 4;
        const int nt = item < NCHP ? CH : 4;
        __syncthreads();
        for (int i = tid; i < nt * 16; i += 512) lrs[i] = LR[(size_t)tok0 * 16 + i];
        __syncthreads();
        float bc = 0.f;
        for (int t = 0; t < nt; ++t) {
            float x = bias;
#pragma unroll
            for (int j = 0; j < 16; j += 4) { const f32x4 l4 = *(const LAS f32x4*)(lrs + t * 16 + j); x += l4[0] * w[j] + l4[1] * w[j + 1] + l4[2] * w[j + 2] + l4[3] * w[j + 3]; }
            const float ls = fminf(x, 0.f) - log1pf(expf(-fabsf(x)));
            bc += ls * 0.0625f;
            ebuf[t * 512 + tid] = expf(bc);
        }
        LAM[(size_t)item * 512 + tid] = expf(bc);
        __syncthreads();
        for (int it = tid; it < nt * 64; it += 512) {
            const int t = it >> 6, c8 = (it & 63) * 8;
            bf16_t* pr = P + (size_t)(tok0 + t) * PW;
            const u32x4 qv = *(const u32x4*)(pr + C_QG + c8), kv = *(const u32x4*)(pr + C_KG + c8);
            const f32x4 e0 = *(const LAS f32x4*)(ebuf + t * 512 + c8), e1 = *(const LAS f32x4*)(ebuf + t * 512 + c8 + 4);
            const float ev[8] = {e0[0], e0[1], e0[2], e0[3], e1[0], e1[1], e1[2], e1[3]};
            const unsigned qw[4] = {qv.x, qv.y, qv.z, qv.w}, kw[4] = {kv.x, kv.y, kv.z, kv.w}; unsigned qo[4], ko[4];
#pragma unroll
            for (int j = 0; j < 4; ++j) {
                const float ea = ev[2 * j], eb = ev[2 * j + 1];
                qo[j] = pk2(bflo(qw[j]) * ea * 0.08838834764831845f, bfhi(qw[j]) * eb * 0.08838834764831845f);
                ko[j] = pk2(bflo(kw[j]) / ea, bfhi(kw[j]) / eb);
            }
            u32x4 o; o.x = qo[0]; o.y = qo[1]; o.z = qo[2]; o.w = qo[3]; *(u32x4*)(pr + C_QG + c8) = o;
            o.x = ko[0]; o.y = ko[1]; o.z = ko[2]; o.w = ko[3]; *(u32x4*)(pr + C_KG + c8) = o;
        }
    }
}

template <int RS> DI int imgaddr(int row, int col) {
    const int swz = RS == 128 ? ((row >> 1) & 7) : (row & 15);
    return row * RS + ((((col >> 3) ^ swz)) << 4) + ((col & 7) << 1);
}
template <int RS> DI bf16x8 frag(const LAS unsigned char* base, int rb, int ks, int lane) {
    return *(const LAS bf16x8*)(base + imgaddr<RS>(16 * rb + (lane & 15), 32 * ks + 8 * (lane >> 4)));
}
#define MFMA16(a, b, c) __builtin_amdgcn_mfma_f32_16x16x32_bf16((a), (b), (c), 0, 0, 0)

template <int DK, bool RET>
DI void prompt_task(const Params& p, LAS unsigned char* lds, int b, int h, int slice) {
    constexpr int RSQ = DK * 2;
    constexpr int OFF_Q = 0, OFF_K = 64 * RSQ, OFF_KT = 2 * 64 * RSQ, OFF_VT = OFF_KT + DK * 128, OFF_P = OFF_VT + 8192, OFF_S = OFF_P + 8192;
    constexpr int CPR = DK / 8;
    constexpr int NQ = 64 * CPR / 512;
    constexpr int NDB = DK / 128;
    constexpr int DV = RET ? 512 : 256;
    const int tid = threadIdx.x, lane = tid & 63, w = __builtin_amdgcn_readfirstlane(tid >> 6), r = lane & 15, g = lane >> 4;
    const bf16_t* P = (const bf16_t*)(p.ws + WS_P);
    bf16_t* O = (bf16_t*)(p.ws + WS_O); float* STAT = (float*)(p.ws + WS_STAT); const float* LAM = (const float*)(p.ws + WS_LAM);
    const int colQ = (RET ? C_QR : C_QG) + h * DK, colK = (RET ? C_KR : C_KG) + h * DK, colV = (RET ? C_VR : C_VG) + h * DV + slice * 64;
    const int ocol = (RET ? 1024 : 0) + h * DV + slice * 64;
    const int headidx = RET ? 4 + h : h;
    const float l2g = RET ? __log2f(1.0f - exp2f(-5.0f - (float)h)) : 0.f;
    const float gC = RET ? exp2f((float)CH * l2g) : 1.f;

    f32x4 accS[NDB][4];
#pragma unroll
    for (int j = 0; j < NDB; ++j)
#pragma unroll
        for (int v = 0; v < 4; ++v) accS[j][v] = (f32x4){0.f, 0.f, 0.f, 0.f};
    __syncthreads();
    for (int i = tid; i < 64 * RSQ / 16; i += 512) *(LAS u32x4*)(lds + OFF_S + i * 16) = (u32x4){0u, 0u, 0u, 0u};

    constexpr int NKI = 32 * CPR / 512;
    u32x4 rq[NQ], rk[NKI][2], rv[2];
    unsigned pfv = 0u, pfo = 0u, pfacc = 0u;
    const int vsp = tid & 31, vch = tid >> 5;
    rv[0] = (u32x4){0u, 0u, 0u, 0u}; rv[1] = rv[0];
    {
        const size_t tok0 = (size_t)b * TP;
#pragma unroll
        for (int i = 0; i < NQ; ++i) { const int id = tid + 512 * i, row = id / CPR, ch = id % CPR; rq[i] = *(const u32x4*)(P + (tok0 + row) * PW + colQ + ch * 8); }
#pragma unroll
        for (int j = 0; j < NKI; ++j) { const int id = tid + 512 * j, sp = id & 31, ch = id >> 5;
            rk[j][0] = *(const u32x4*)(P + (tok0 + 2 * sp) * PW + colK + ch * 8); rk[j][1] = *(const u32x4*)(P + (tok0 + 2 * sp + 1) * PW + colK + ch * 8); }
        if (tid < 256) { rv[0] = *(const u32x4*)(P + (tok0 + 2 * vsp) * PW + colV + vch * 8); rv[1] = *(const u32x4*)(P + (tok0 + 2 * vsp + 1) * PW + colV + vch * 8); }
    }
    for (int c = 0; c < TP / CH; ++c) {
        const size_t tok0 = (size_t)b * TP + (size_t)c * CH;
#pragma unroll
        for (int i = 0; i < NQ; ++i) { const int id = tid + 512 * i, row = id / CPR, ch = id % CPR; *(LAS u32x4*)(lds + OFF_Q + imgaddr<RSQ>(row, ch * 8)) = rq[i]; }
#pragma unroll
        for (int j = 0; j < NKI; ++j) { const int id = tid + 512 * j, sp = id & 31, ch = id >> 5;
            *(LAS u32x4*)(lds + OFF_K + imgaddr<RSQ>(2 * sp, ch * 8)) = rk[j][0];
            *(LAS u32x4*)(lds + OFF_K + imgaddr<RSQ>(2 * sp + 1, ch * 8)) = rk[j][1];
            const unsigned k0[4] = {rk[j][0].x, rk[j][0].y, rk[j][0].z, rk[j][0].w}, k1[4] = {rk[j][1].x, rk[j][1].y, rk[j][1].z, rk[j][1].w};
#pragma unroll
            for (int e = 0; e < 8; ++e) { const unsigned lo = (k0[e >> 1] >> ((e & 1) * 16)) & 0xffffu, hi = (k1[e >> 1] >> ((e & 1) * 16)) & 0xffffu;
                *(LAS unsigned*)(lds + OFF_KT + imgaddr<128>(ch * 8 + e, 2 * sp)) = lo | (hi << 16); }
        }
        if (tid < 256) { const unsigned v0[4] = {rv[0].x, rv[0].y, rv[0].z, rv[0].w}, v1[4] = {rv[1].x, rv[1].y, rv[1].z, rv[1].w};
#pragma unroll
            for (int e = 0; e < 8; ++e) { const unsigned lo = (v0[e >> 1] >> ((e & 1) * 16)) & 0xffffu, hi = (v1[e >> 1] >> ((e & 1) * 16)) & 0xffffu;
                *(LAS unsigned*)(lds + OFF_VT + imgaddr<128>(vch * 8 + e, 2 * vsp)) = lo | (hi << 16); } }
        __syncthreads();
        pfacc ^= pfo; pfo = pfv;
        if (c + 2 < TP / CH) {
            const size_t t2 = tok0 + 2 * CH;
            constexpr int NSL = RET ? 8 : 4, LPR = DK / 64  , NLN = 2 * 64 * LPR / NSL  ;
            if (tid < NLN) { const int line = tid * NSL + slice, which = line / (64 * LPR), row = (line % (64 * LPR)) / LPR, seg = line % LPR;
                pfv = *(const unsigned*)(P + (t2 + row) * PW + (which ? colK : colQ) + seg * 64); }
            else if (tid >= 256 && tid < 320) pfv = *(const unsigned*)(P + (t2 + (tid - 256)) * PW + colV);
        }
        if (c + 1 < TP / CH) {
            const size_t tn = tok0 + CH;
#pragma unroll
            for (int i = 0; i < NQ; ++i) { const int id = tid + 512 * i, row = id / CPR, ch = id % CPR; rq[i] = *(const u32x4*)(P + (tn + row) * PW + colQ + ch * 8); }
#pragma unroll
            for (int j = 0; j < NKI; ++j) { const int id = tid + 512 * j, sp = id & 31, ch = id >> 5;
                rk[j][0] = *(const u32x4*)(P + (tn + 2 * sp) * PW + colK + ch * 8); rk[j][1] = *(const u32x4*)(P + (tn + 2 * sp + 1) * PW + colK + ch * 8); }
            if (tid < 256) { rv[0] = *(const u32x4*)(P + (tn + 2 * vsp) * PW + colV + vch * 8); rv[1] = *(const u32x4*)(P + (tn + 2 * vsp + 1) * PW + colV + vch * 8); }
        }
        {
            const int tb = w & 3, sh = w >> 2;
            f32x4 a1[2]; a1[0] = (f32x4){0.f, 0.f, 0.f, 0.f}; a1[1] = a1[0];
            if (!(sh == 1 && tb < 2)) {
#pragma unroll 4
                for (int ks = 0; ks < DK / 32; ++ks) {
                    const bf16x8 qB = frag<RSQ>(lds + OFF_Q, tb, ks, lane);
                    const bf16x8 k0 = frag<RSQ>(lds + OFF_K, 2 * sh, ks, lane), k1 = frag<RSQ>(lds + OFF_K, 2 * sh + 1, ks, lane);
                    a1[0] = MFMA16(k0, qB, a1[0]); a1[1] = MFMA16(k1, qB, a1[1]);
                }
            }
#pragma unroll
            for (int i = 0; i < 2; ++i) { const int t = 16 * tb + r, s0 = 16 * (2 * sh + i) + 4 * g;
                const float e0 = (s0 + 0 <= t) ? a1[i][0] : 0.f, e1 = (s0 + 1 <= t) ? a1[i][1] : 0.f, e2 = (s0 + 2 <= t) ? a1[i][2] : 0.f, e3 = (s0 + 3 <= t) ? a1[i][3] : 0.f;
                u32x2 pw; pw.x = pk2(e0, e1); pw.y = pk2(e2, e3);
                *(LAS u32x2*)(lds + OFF_P + imgaddr<128>(t, s0)) = pw; }
        }
        __syncthreads();
        {
            const int tb = w & 3, vb0 = 2 * (w >> 2);
            f32x4 a2[2]; a2[0] = (f32x4){0.f, 0.f, 0.f, 0.f}; a2[1] = a2[0];
#pragma unroll
            for (int ks = 0; ks < 2; ++ks) {
                const bf16x8 pB = frag<128>(lds + OFF_P, tb, ks, lane);
#pragma unroll
                for (int i = 0; i < 2; ++i) { const bf16x8 vA = frag<128>(lds + OFF_VT, vb0 + i, ks, lane); a2[i] = MFMA16(vA, pB, a2[i]); }
            }
#pragma unroll 4
            for (int ks = 0; ks < DK / 32; ++ks) {
                const bf16x8 qB = frag<RSQ>(lds + OFF_Q, tb, ks, lane);
#pragma unroll
                for (int i = 0; i < 2; ++i) { const bf16x8 sA = frag<RSQ>(lds + OFF_S, vb0 + i, ks, lane); a2[i] = MFMA16(sA, qB, a2[i]); }
            }
            const int tl = 16 * tb + r; const size_t token = tok0 + tl;
            const float sc = RET ? exp2f((float)(tl + 1) * l2g) : 1.f;
            float s1 = 0.f, s2 = 0.f;
#pragma unroll
            for (int i = 0; i < 2; ++i) { a2[i] = a2[i] * sc;
                s1 += (a2[i][0] + a2[i][1]) + (a2[i][2] + a2[i][3]);
                s2 += (a2[i][0] * a2[i][0] + a2[i][1] * a2[i][1]) + (a2[i][2] * a2[i][2] + a2[i][3] * a2[i][3]);
                u32x2 ow; ow.x = pk2(a2[i][0], a2[i][1]); ow.y = pk2(a2[i][2], a2[i][3]);
                *(u32x2*)(O + token * UW + ocol + 16 * (vb0 + i) + 4 * g) = ow; }
            s1 += __shfl_xor(s1, 16); s1 += __shfl_xor(s1, 32); s2 += __shfl_xor(s2, 16); s2 += __shfl_xor(s2, 32);
            if (g == 0) { float* so = STAT + ((token * 8 + headidx) * 16 + slice * 2 + (w >> 2)) * 2; so[0] = s1; so[1] = s2; }
        }
        {
#pragma unroll
            for (int ks = 0; ks < 2; ++ks) {
                bf16x8 vB[4];
#pragma unroll
                for (int v = 0; v < 4; ++v) vB[v] = frag<128>(lds + OFF_VT, v, ks, lane);
#pragma unroll
                for (int j = 0; j < NDB; ++j) { const bf16x8 kA = frag<128>(lds + OFF_KT, w * NDB + j, ks, lane);
#pragma unroll
                    for (int v = 0; v < 4; ++v) accS[j][v] = MFMA16(kA, vB[v], accS[j][v]); }
            }
#pragma unroll
            for (int j = 0; j < NDB; ++j) {
                f32x4 lam;
                if (RET) lam = (f32x4){gC, gC, gC, gC};
                else lam = *(const f32x4*)(LAM + (size_t)(b * (TP / CH) + c) * 512 + h * 128 + 16 * (w * NDB + j) + 4 * g);
#pragma unroll
                for (int v = 0; v < 4; ++v) accS[j][v] = accS[j][v] * lam;
            }
        }
        __syncthreads();
#pragma unroll
        for (int j = 0; j < NDB; ++j)
#pragma unroll
            for (int v = 0; v < 4; ++v) { u32x2 sw; sw.x = pk2(accS[j][v][0], accS[j][v][1]); sw.y = pk2(accS[j][v][2], accS[j][v][3]);
                *(LAS u32x2*)(lds + OFF_S + imgaddr<RSQ>(16 * v + r, 16 * (w * NDB + j) + 4 * g)) = sw; }
    }
    pfacc ^= pfv ^ pfo;
    if (pfacc == 0x9e3779b9u) ((unsigned*)(p.ws + WS_CTL))[8] = pfacc;
    float* So = p.out + (RET ? OUT_SRP : OUT_SGP) + ((size_t)(b * 4 + h) * DK) * DV + slice * 64;
#pragma unroll
    for (int j = 0; j < NDB; ++j)
#pragma unroll
        for (int v = 0; v < 4; ++v)
#pragma unroll
            for (int e = 0; e < 4; ++e) So[(size_t)(16 * (w * NDB + j) + 4 * g + e) * DV + 16 * v + r] = accS[j][v][e];
}

template <int DK, bool RET>
DI void sample_task(const Params& p, LAS unsigned char* lds, int b, int h) {
    constexpr int DV = RET ? 512 : 256;
    constexpr int NCG = DV / 4;
    constexpr int NRG = 512 / NCG;
    constexpr int RPT = DK / NRG;
    const int tid = threadIdx.x, lane = tid & 63, w = tid >> 6;
    const bf16_t* P = (const bf16_t*)(p.ws + WS_P); bf16_t* U = (bf16_t*)(p.ws + WS_U); const float* LAM = (const float*)(p.ws + WS_LAM);
    const int colQ = (RET ? C_QR : C_QG) + h * DK, colK = (RET ? C_KR : C_KG) + h * DK, colV = (RET ? C_VR : C_VG) + h * DV, colZ = (RET ? C_ZR : C_ZG) + h * DV;
    const int ucol = (RET ? 1024 : 0) + h * DV;
    const size_t tok0 = (size_t)NTP + (size_t)b * 4;
    const float l2g = RET ? __log2f(1.0f - exp2f(-5.0f - (float)h)) : 0.f;
    LAS float* qs = (LAS float*)lds;
    LAS float* ks = qs + 4 * DK;
    LAS float* lam = ks + 4 * DK;
    LAS float* am = lam + DK;
    LAS float* st = am + 16;
    LAS float* red = (LAS float*)(lds + 16384);
    __syncthreads();
    for (int i = tid; i < 4 * DK; i += 512) { const int t = i / DK, d = i % DK;
        qs[i] = bf1(P[(tok0 + t) * PW + colQ + d]); ks[i] = bf1(P[(tok0 + t) * PW + colK + d]); }
    for (int i = tid; i < DK; i += 512) lam[i] = RET ? exp2f(4.0f * l2g) : LAM[(size_t)(NCHP + b) * 512 + h * 128 + i];
    __syncthreads();
    for (int pr = w; pr < 16; pr += 8) { const int t = pr >> 2, s = pr & 3; float a = 0.f;
        for (int d = lane; d < DK; d += 64) a += qs[t * DK + d] * ks[s * DK + d];
        a = wave_sum(a); if (lane == 0) am[pr] = (s <= t) ? a : 0.f; }
    const int cg = tid % NCG, rg = tid / NCG;
    f32x4 vv[4], oo[4];
#pragma unroll
    for (int t = 0; t < 4; ++t) { const u32x2 x = *(const u32x2*)(P + (tok0 + t) * PW + colV + 4 * cg);
        vv[t] = (f32x4){bflo(x.x), bfhi(x.x), bflo(x.y), bfhi(x.y)}; oo[t] = (f32x4){0.f, 0.f, 0.f, 0.f}; }
    const float* S0 = p.in[RET ? 3 : 2] + ((size_t)(b * 4 + h) * DK) * DV + 4 * cg;
    float* S1 = p.out + (RET ? OUT_SRS : OUT_SGS) + ((size_t)(b * 4 + h) * DK) * DV + 4 * cg;
    constexpr int SB = 16;
    for (int i0 = 0; i0 < RPT; i0 += SB) {
        f32x4 sv[SB];
#pragma unroll
        for (int q = 0; q < SB; ++q) sv[q] = __builtin_nontemporal_load((const f32x4*)(S0 + (size_t)(rg + NRG * (i0 + q)) * DV));
#pragma unroll
        for (int q = 0; q < SB; ++q) {
            const int d = rg + NRG * (i0 + q);
            f32x4 n = sv[q];
#pragma unroll
            for (int t = 0; t < 4; ++t) { n += vv[t] * ks[t * DK + d]; oo[t] += sv[q] * qs[t * DK + d]; }
            __builtin_nontemporal_store(n * lam[d], (f32x4*)(S1 + (size_t)d * DV));
        }
    }
#pragma unroll
    for (int t = 0; t < 4; ++t) *(LAS f32x4*)(red + ((rg * 4 + t) * DV + 4 * cg)) = oo[t];
    __syncthreads();
    const int ft = tid / NCG, fcg = tid % NCG; const bool fin = tid < 4 * NCG;
    f32x4 o = (f32x4){0.f, 0.f, 0.f, 0.f};
    if (fin) {
#pragma unroll
        for (int q = 0; q < NRG; ++q) o += *(const LAS f32x4*)(red + ((q * 4 + ft) * DV + 4 * fcg));
#pragma unroll
        for (int s = 0; s < 4; ++s) o += vv[s] * am[ft * 4 + s];
        if (RET) o = o * exp2f((float)(ft + 1) * l2g);
        float s1 = (o[0] + o[1]) + (o[2] + o[3]), s2 = (o[0] * o[0] + o[1] * o[1]) + (o[2] * o[2] + o[3] * o[3]);
        s1 = wave_sum(s1); s2 = wave_sum(s2);
        if (lane == 0) { st[w * 2] = s1; st[w * 2 + 1] = s2; }
    }
    __syncthreads();
    if (fin) {
        constexpr int WPT = NCG / 64;
        float s1 = 0.f, s2 = 0.f;
#pragma unroll
        for (int q = 0; q < WPT; ++q) { s1 += st[(ft * WPT + q) * 2]; s2 += st[(ft * WPT + q) * 2 + 1]; }
        float mu = 0.f, rstd;
        if (RET) { mu = s1 * (1.0f / DV); rstd = rsqrtf(fmaxf(s2 * (1.0f / DV) - mu * mu, 0.f) + HN_EPS); }
        else rstd = rsqrtf(s2 * (1.0f / DV) + HN_EPS);
        const float* gn = p.in[RET ? 12 : 11] + h * DV + 4 * fcg;
        const f32x4 gv = *(const f32x4*)gn;
        const u32x2 zx = *(const u32x2*)(P + (tok0 + ft) * PW + colZ + 4 * fcg);
        const f32x4 z = (f32x4){bflo(zx.x), bfhi(zx.x), bflo(zx.y), bfhi(zx.y)};
        f32x4 u;
#pragma unroll
        for (int e = 0; e < 4; ++e) u[e] = (o[e] - mu) * rstd * gv[e] * siluf_(z[e]);
        u32x2 uw; uw.x = pk2(u[0], u[1]); uw.y = pk2(u[2], u[3]);
        *(u32x2*)(U + (tok0 + ft) * UW + ucol + 4 * fcg) = uw;
    }
}

DI void phase4(const Params& p, LAS unsigned char* lds) {
    const int bx = blockIdx.x;
    volatile LAS unsigned* MISC = (volatile LAS unsigned*)(lds + LDS_MISC);
#ifndef REP4
#define REP4 0
#endif
    if (gridDim.x == 256) {
        const int xcd = bx & 7, i = bx >> 3;
        for (int rep = 0; rep < 1 + (REP4 & 1); ++rep)
        { const int grp = xcd * 4 + (i >> 3); prompt_task<256, true>(p, lds, grp >> 2, grp & 3, i & 7); }
        for (int rep = 0; rep < 1 + ((REP4 >> 1) & 1); ++rep)
        if (i < 16) { const int grp = xcd * 4 + (i >> 2); prompt_task<128, false>(p, lds, grp >> 2, grp & 3, i & 3); }
    } else {
        for (int t = bx; t < 256; t += gridDim.x) prompt_task<256, true>(p, lds, t >> 5, (t >> 3) & 3, t & 7);
        for (int t = bx; t < 128; t += gridDim.x) prompt_task<128, false>(p, lds, t >> 4, (t >> 2) & 3, t & 3);
    }
    unsigned* qctr = (unsigned*)(p.ws + WS_CTL) + 64;
    for (;;) {
        __syncthreads();
        if (threadIdx.x == 0) MISC[4] = __hip_atomic_fetch_add(qctr, 1u, __ATOMIC_RELAXED, __HIP_MEMORY_SCOPE_AGENT);
        __syncthreads();
        const int t = (int)MISC[4];
        if (t >= 1024) break;
        if (t < 512) sample_task<256, true>(p, lds, t >> 2, t & 3);
        else sample_task<128, false>(p, lds, (t - 512) >> 2, t & 3);
    }
}


template <int K, int KB  >
DI void tail_mma(const bf16_t* __restrict__ Arow, const bf16_t* __restrict__ Wrow, f32x4& acc) {
    for (int k0 = 0; k0 < K; k0 += 32 * KB) {
        bf16x8 a[KB], w[KB];
#pragma unroll
        for (int j = 0; j < KB; ++j) { a[j] = *(const bf16x8*)(Arow + k0 + 32 * j); w[j] = *(const bf16x8*)(Wrow + k0 + 32 * j); }
#pragma unroll
        for (int j = 0; j < KB; ++j) acc = MFMA16(w[j], a[j], acc);
    }
}
DI void tail_branch(const Params& p) {
    const int lane = threadIdx.x & 63, r = lane & 15, g = lane >> 4;
    const int gw = blockIdx.x * 8 + (threadIdx.x >> 6), NGW = gridDim.x * 8;
    const bf16_t* U = (const bf16_t*)(p.ws + WS_U); const bf16_t* W = (const bf16_t*)(p.ws + WS_WBR); const bf16_t* P = (const bf16_t*)(p.ws + WS_P); bf16_t* MRG = (bf16_t*)(p.ws + WS_MRG);
    for (int tile = gw; tile < 32 * 64; tile += NGW) {
        const int t0 = NTP + (tile >> 6) * 16, n0 = (tile & 63) * 16;
        const bf16_t* Ar = U + (size_t)(t0 + r) * UW + 8 * g; const bf16_t* Wr = W + (size_t)(n0 + r) * UW + 8 * g;
        f32x4 acc = (f32x4){0.f, 0.f, 0.f, 0.f};
        tail_mma<1024, 8>(Ar, Wr, acc);
        const u32x2 gq = *(const u32x2*)(P + (size_t)(t0 + r) * PW + C_MG + n0 + 4 * g), rq = *(const u32x2*)(P + (size_t)(t0 + r) * PW + C_MR + n0 + 4 * g);
        const float mg[4] = {bflo(gq.x), bfhi(gq.x), bflo(gq.y), bfhi(gq.y)};
        float mr[4] = {bflo(rq.x), bfhi(rq.x), bflo(rq.y), bfhi(rq.y)};
#pragma unroll
        for (int e = 0; e < 4; ++e) { mr[e] = fmaxf(mr[e], -60.f); acc[e] *= (1.0f + __expf(-mr[e])) / (1.0f + __expf(-mg[e])); }
        tail_mma<2048, 8>(Ar + 1024, Wr + 1024, acc);
        u32x2 o; o.x = pk2(acc[0] * sigmoidf_(mr[0]), acc[1] * sigmoidf_(mr[1])); o.y = pk2(acc[2] * sigmoidf_(mr[2]), acc[3] * sigmoidf_(mr[3]));
        *(u32x2*)(MRG + (size_t)(t0 + r) * DM + n0 + 4 * g) = o;
    }
}
DI void tail_out(const Params& p) {
    const int lane = threadIdx.x & 63, r = lane & 15, g = lane >> 4;
    const int gw = blockIdx.x * 8 + (threadIdx.x >> 6), NGW = gridDim.x * 8;
    const bf16_t* A = (const bf16_t*)(p.ws + WS_MRG); const bf16_t* W = (const bf16_t*)(p.ws + WS_WO); const float* ADA = (const float*)(p.ws + WS_ADA);
    float* Y = p.out + OUT_Y;
    for (int tile = gw; tile < 32 * 64; tile += NGW) {
        const int t0 = NTP + (tile >> 6) * 16, n0 = (tile & 63) * 16;
        const int row = t0 + r;
        const bf16_t* Ar = A + (size_t)row * DM + 8 * g; const bf16_t* Wr = W + (size_t)(n0 + r) * DM + 8 * g;
        f32x4 acc = (f32x4){0.f, 0.f, 0.f, 0.f};
        tail_mma<1024, 8>(Ar, Wr, acc);
        const int c = n0 + 4 * g;
        const f32x4 xv = *(const f32x4*)(p.in[1] + (size_t)(row - NTP) * DM + c);
        const f32x4 gv = *(const f32x4*)(ADA + (size_t)(NB_P + ((row - NTP) >> 2)) * 3072 + 2048 + c);
        *(f32x4*)(Y + (size_t)row * DM + c) = xv * DN_ALPHA + gv * acc;
    }
}

DI void phase5(const Params& p) {
    const int tid = threadIdx.x, lane = tid & 63, wave = tid >> 6;
    const int gw = blockIdx.x * 8 + wave, NGW = gridDim.x * 8;
    const bf16_t* P = (const bf16_t*)(p.ws + WS_P); const bf16_t* O = (const bf16_t*)(p.ws + WS_O); bf16_t* U = (bf16_t*)(p.ws + WS_U);
    const float* STAT = (const float*)(p.ws + WS_STAT);
    for (int row = gw; row < NTP; row += NGW) {
        u32x4 ovv[6], zvv[6];
#pragma unroll
        for (int j = 0; j < 6; ++j) { const int c = 8 * lane + 512 * j;
            ovv[j] = *(const u32x4*)(O + (size_t)row * UW + c);
            zvv[j] = *(const u32x4*)(P + (size_t)row * PW + (c < 1024 ? C_ZG + c : C_ZR + (c - 1024))); }
        float mu, rstd;
        {
            const f32x4 sv = *(const f32x4*)(STAT + (size_t)row * 256 + lane * 4);
            float s1 = sv[0] + sv[2], s2 = sv[1] + sv[3];
            if (lane < 32 && (lane & 7) >= 4) { s1 = 0.f; s2 = 0.f; }
            s1 += __shfl_xor(s1, 1); s2 += __shfl_xor(s2, 1); s1 += __shfl_xor(s1, 2); s2 += __shfl_xor(s2, 2); s1 += __shfl_xor(s1, 4); s2 += __shfl_xor(s2, 4);
            if (lane < 32) { mu = 0.f; rstd = rsqrtf(s2 * (1.0f / 256.f) + HN_EPS); }
            else { mu = s1 * (1.0f / 512.f); rstd = rsqrtf(fmaxf(s2 * (1.0f / 512.f) - mu * mu, 0.f) + HN_EPS); }
        }
#pragma unroll
        for (int j = 0; j < 6; ++j) {
            const int c = 8 * lane + 512 * j;
            const int hd = c < 1024 ? (c >> 8) : 4 + ((c - 1024) >> 9);
            const float m = __shfl(mu, hd * 8), rs = __shfl(rstd, hd * 8);
            const u32x4 ov = ovv[j], zv = zvv[j];
            const float* gp = c < 1024 ? p.in[11] + c : p.in[12] + (c - 1024);
            const f32x4 g0 = *(const f32x4*)gp, g1 = *(const f32x4*)(gp + 4);
            const unsigned ow[4] = {ov.x, ov.y, ov.z, ov.w}, zw[4] = {zv.x, zv.y, zv.z, zv.w}; unsigned uw[4];
#pragma unroll
            for (int q = 0; q < 4; ++q) {
                const float ga = q < 2 ? g0[2 * q] : g1[2 * q - 4], gb = q < 2 ? g0[2 * q + 1] : g1[2 * q - 3];
                const float a = (bflo(ow[q]) - m) * rs * ga * siluf_(bflo(zw[q])), bb = (bfhi(ow[q]) - m) * rs * gb * siluf_(bfhi(zw[q]));
                uw[q] = pk2(a, bb);
            }
            u32x4 o; o.x = uw[0]; o.y = uw[1]; o.z = uw[2]; o.w = uw[3];
            *(u32x4*)(U + (size_t)row * UW + c) = o;
        }
    }
}

DI void phase8(const Params& p) {
    const int tid = threadIdx.x, lane = tid & 63, wave = tid >> 6;
    const int gw = blockIdx.x * 8 + wave, NGW = gridDim.x * 8;
    float* Y = p.out + OUT_Y; const float* YST = (const float*)(p.ws + WS_YST);
    const float* lg = p.in[16]; const float* lb = p.in[17];
    f32x4 gv[4], bv[4];
#pragma unroll
    for (int j = 0; j < 4; ++j) { const int c = 4 * lane + 256 * j; gv[j] = *(const f32x4*)(lg + c); bv[j] = *(const f32x4*)(lb + c); }
    for (int row = gw; row < NTOK; row += NGW) {
        f32x4 v[4];
#pragma unroll
        for (int j = 0; j < 4; ++j) v[j] = *(const f32x4*)(Y + (size_t)row * DM + 4 * lane + 256 * j);
        float s1 = 0.f;
#pragma unroll
        for (int j = 0; j < 4; ++j) s1 += (v[j][0] + v[j][1]) + (v[j][2] + v[j][3]);
        const float mean = wave_sum(s1) * (1.0f / DM); float s2 = 0.f;
#pragma unroll
        for (int j = 0; j < 4; ++j) { v[j] = v[j] - mean; s2 += (v[j][0] * v[j][0] + v[j][1] * v[j][1]) + (v[j][2] * v[j][2] + v[j][3] * v[j][3]); }
        const float rstd = rsqrtf(wave_sum(s2) * (1.0f / DM) + LN_EPS);
#pragma unroll
        for (int j = 0; j < 4; ++j) *(f32x4*)(Y + (size_t)row * DM + 4 * lane + 256 * j) = v[j] * rstd * gv[j] + bv[j];
    }
}

constexpr int NPHASE = 9;
__global__ void __launch_bounds__(512, 2) fwd_kernel(Params p) {
    extern __shared__ __attribute__((aligned(16))) unsigned char lds_raw[];
    LAS unsigned char* lds = (LAS unsigned char*)lds_raw;
    volatile LAS unsigned* MISC = (volatile LAS unsigned*)(lds + LDS_MISC);
    const int tid = threadIdx.x;
    for (int u = tid; u < (LDS_BYTES - LDS_MISC) / 4; u += 512) ((LAS unsigned*)(lds + LDS_MISC))[u] = 0u;
    __syncthreads();
    const int lo = p.ph_lo, hi = p.ph_hi;
    XcdBarrier bar; bar.bar = (unsigned*)(p.ws + WS_CTL) + CW_BAR; bar.x = 0; bar.st = nullptr;
    if (hi - lo > 1) bar = xcd_barrier_post((unsigned*)(p.ws + WS_CTL) + CW_BAR, MISC + 8);
#ifndef PHMASK
#define PHMASK 0x1ff
#endif
#define IN(k) (((PHMASK >> (k)) & 1) && lo <= (k) && (k) < hi)
#define SEAM(k) do { if (IN(k) && IN((k) + 1)) xcd_barrier(bar); } while (0)
    unsigned char* ws = p.ws;
#ifndef REPMASK
#define REPMASK 0
#endif
#define REP(k) ((REPMASK >> (k)) & 1)
#define P2BODY do { pg8::Gemm g{(const bf16_t*)(ws + WS_H), (const bf16_t*)(ws + WS_WIN), NTOK, NIN, DM}; \
        pg8::StaticOrder S; S.init(NTOK, NIN, gridDim.x, blockIdx.x); \
        EpiIn E{(bf16_t*)(ws + WS_P), (float*)(ws + WS_LR), (const float*)(ws + WS_COS), (const float*)(ws + WS_SIN)}; \
        pg8::gemm_phase<EpiIn, pg8::StaticOrder>(lds, g, S, E); } while (0)
#define P6BODY do { pg8::Gemm g{(const bf16_t*)(ws + WS_U), (const bf16_t*)(ws + WS_WBR), NTP, DM, UW}; \
        pg8::StaticOrder S; S.init(NTP, DM, gridDim.x, blockIdx.x); \
        EpiBranch E{(const bf16_t*)(ws + WS_P), (bf16_t*)(ws + WS_MRG)}; \
        pg8::gemm_phase<EpiBranch, pg8::StaticOrder>(lds, g, S, E); } while (0)
#define P7BODY do { tail_out(p); pg8::Gemm g{(const bf16_t*)(ws + WS_MRG), (const bf16_t*)(ws + WS_WO), NTP, DM, DM}; \
        pg8::StaticOrder S; S.init(NTP, DM, gridDim.x, blockIdx.x); \
        EpiOut E{p.in[0], p.in[1], (const float*)(ws + WS_ADA), p.out + OUT_Y, (float*)(ws + WS_YST)}; \
        pg8::gemm_phase<EpiOut, pg8::StaticOrder>(lds, g, S, E); } while (0)
    if (IN(0)) { phase0(p, lds); if (REP(0)) { xcd_barrier(bar); phase0(p, lds); } } SEAM(0);
    if (IN(1)) { phase0b(p, lds); phase1(p); if (REP(1)) { xcd_barrier(bar); phase0b(p, lds); phase1(p); } } SEAM(1);
    if (IN(2)) { P2BODY; if (REP(2)) { xcd_barrier(bar); P2BODY; } } SEAM(2);
    if (IN(3)) { phase3(p, lds); if (REP(3)) { xcd_barrier(bar); P2BODY; xcd_barrier(bar); phase3(p, lds); } } SEAM(3);
    if (IN(4)) { phase4(p, lds); if (REP(4)) { xcd_barrier(bar); phase4(p, lds); } } SEAM(4);
    if (IN(5)) {
        { const int par = __builtin_amdgcn_readfirstlane((int)(threadIdx.x >> 6)) & 1;
#pragma unroll 1
          for (int stp = 0; stp < 2; ++stp) { if ((stp ^ par) == 0) tail_branch(p); else phase5(p); } }
        if (REP(5)) { xcd_barrier(bar); phase5(p); tail_branch(p); } } SEAM(5);
    if (IN(6)) { P6BODY; if (REP(6)) { xcd_barrier(bar); P6BODY; } } SEAM(6);
    if (IN(7)) { P7BODY; if (REP(7)) { xcd_barrier(bar); P7BODY; } } SEAM(7);
    if (IN(8)) { phase8(p); if (REP(8)) { xcd_barrier(bar); P7BODY; xcd_barrier(bar); phase8(p); } }
}

#ifndef N_LAUNCH_SPLIT
#define N_LAUNCH_SPLIT 0
#endif

extern "C" void kernel_launch(void* const* d_in, const int* in_sizes, int n_in, void* d_out, int out_size, void* d_ws, size_t ws_size, hipStream_t stream) {
    static int ready = 0;
    if (!ready) {
        if (n_in != 18 || ws_size < WS_END) { fprintf(stderr, "kernel_launch: unexpected n_in %d or ws_size %zu (need %zu)\n", n_in, ws_size, (size_t)WS_END); }
        if (hipFuncSetAttribute((const void*)fwd_kernel, hipFuncAttributeMaxDynamicSharedMemorySize, LDS_BYTES) != hipSuccess) fprintf(stderr, "kernel_launch: hipFuncSetAttribute failed\n");
        ready = 1;
    }
    Params p; memset(&p, 0, sizeof(p));
    for (int i = 0; i < 18; ++i) p.in[i] = (const float*)d_in[i];
    p.out = (float*)d_out; p.ws = (unsigned char*)d_ws;
    (void)hipMemsetAsync((char*)d_ws + WS_CTL, 0, 1 * MiB, stream);
#if N_LAUNCH_SPLIT
    for (int k = 0; k < NPHASE; ++k) { p.ph_lo = k; p.ph_hi = k + 1; hipLaunchKernelGGL(fwd_kernel, dim3(256), dim3(512), LDS_BYTES, stream, p); }
#else
    p.ph_lo = 0; p.ph_hi = NPHASE; hipLaunchKernelGGL(fwd_kernel, dim3(256), dim3(512), LDS_BYTES, stream, p);
#endif
    hipError_t e = hipGetLastError();
    if (e != hipSuccess) fprintf(stderr, "kernel_launch: launch failed: %s\n", hipGetErrorString(e));
}
```
